# Optimizing an MI355X kernel written in HIP

```python
import jax
import jax.numpy as jnp
from jax import lax
import numpy as np

D_MODEL = 1024
BATCH = 8
SEQ = 2048
DEPTH = 2
DEC_BATCH = 128
DEC_SEQ = 8
PAST_LEN = 2048
PAGE_SIZE = 128

H_A = 4
DK_A = D_MODEL // H_A
DV_A = 2 * DK_A
RET_CHUNK = 128
H_B = 16
DH_B = D_MODEL // H_B
G_B = 4
HPG = H_B // G_B
L_CMP = 32
S_CMP = 16
L_SEL = 64
N_SEL = 16
WINDOW = 512
CMP_HID = 2 * DH_B
Q_BLOCK = 128
FORCE_BONUS = 1e4
D_FF = 2816
CONV_W = 3
EPS = 1e-6

kernel_name = 'yoco_retention_nsa_decode_step'


def rmsnorm(x, g):
    xf = x.astype(jnp.float32)
    y = xf * lax.rsqrt(jnp.mean(xf * xf, axis=-1, keepdims=True) + EPS)
    return (y * g.astype(jnp.float32)).astype(x.dtype)


def modulate(h, shift, scale):
    return h * (1.0 + scale[:, None, :]) + shift[:, None, :]


def masked_softmax(s, mask):
    s = jnp.where(mask, s.astype(jnp.float32), -jnp.inf)
    m = jnp.max(s, axis=-1, keepdims=True)
    m = jnp.where(jnp.isfinite(m), m, 0.0)
    e = jnp.where(mask, jnp.exp(s - m), 0.0)
    return e / jnp.maximum(jnp.sum(e, axis=-1, keepdims=True), 1e-30)


def alibi_slopes():
    return jnp.exp2(-8.0 * jnp.arange(1, H_B + 1, dtype=jnp.float32) / H_B)


def retention_log_decay():
    return jnp.log1p(-jnp.exp2(-5.0 - jnp.arange(H_A, dtype=jnp.float32)))


def retention_chunk(S, q, k, v, log_g):
    c = q.shape[1]
    i = jnp.arange(c, dtype=jnp.float32)
    diff = i[:, None] - i[None, :]
    dmask = jnp.where(diff >= 0, jnp.exp(jnp.maximum(diff, 0.0)[None] * log_g[:, None, None]), 0.0)
    scores = jnp.einsum('bihd,bjhd->bhij', q, k) * dmask
    o = jnp.einsum('bhij,bjhv->bihv', scores, v)
    o = o + jnp.einsum('bihd,bhdv->bihv', q, S) * jnp.exp((i[:, None] + 1.0) * log_g[None, :])[None, :, :, None]
    w = jnp.exp((c - 1.0 - i)[:, None] * log_g[None, :])
    kw = k * w[None, :, :, None]
    S_new = jnp.exp(c * log_g)[None, :, None, None] * S + jnp.einsum('bjhd,bjhv->bhdv', kw, v)
    return S_new, o


def retention_mixer(h, S0, w_in, w_out):
    b, t, _ = h.shape
    nq = H_A * DK_A
    nv = H_A * DV_A
    pr = h @ w_in
    q = pr[..., :nq].reshape(b, t, H_A, DK_A)
    k = pr[..., nq:2 * nq].reshape(b, t, H_A, DK_A) * (DK_A ** -0.5)
    v = pr[..., 2 * nq:2 * nq + nv].reshape(b, t, H_A, DV_A)
    g = pr[..., 2 * nq + nv:]
    log_g = retention_log_decay()
    c = RET_CHUNK if t % RET_CHUNK == 0 else t
    nc = t // c
    if nc == 1:
        S, o = retention_chunk(S0, q, k, v, log_g)
    else:
        def to_chunks(a):
            return a.reshape(b, nc, c, *a.shape[2:]).swapaxes(0, 1)

        def step(S, inp):
            qc, kc, vc = inp
            return retention_chunk(S, qc, kc, vc, log_g)

        S, o = lax.scan(step, S0, (to_chunks(q), to_chunks(k), to_chunks(v)))
        o = o.swapaxes(0, 1).reshape(b, t, H_A, DV_A)
    of = o.astype(jnp.float32)
    of = of * lax.rsqrt(jnp.mean(of * of, axis=-1, keepdims=True) + EPS)
    y = (of.reshape(b, t, nv).astype(h.dtype) * jax.nn.silu(g)) @ w_out
    return y, S


def conv_ffn(h, buf, w_in, cw, cb, w_out):
    t = h.shape[1]
    u = h @ w_in
    ext = jnp.concatenate([buf.astype(u.dtype), u], axis=1)
    z = cb
    for j in range(CONV_W):
        z = z + cw[j] * ext[:, j:j + t]
    a, g = jnp.split(z, 2, axis=-1)
    return (jax.nn.silu(g) * a) @ w_out, ext[:, -(CONV_W - 1):]


def compress_branch(rows, pe, w1, w2):
    bx, L = rows.shape[:2]
    r_n = L_CMP // S_CMP
    n_pc = L // S_CMP
    nb = n_pc - r_n + 1
    P = rows[:, :n_pc * S_CMP].reshape(bx, n_pc, S_CMP, G_B, DH_B).transpose(0, 1, 3, 2, 4)
    pe_r = pe.reshape(r_n, S_CMP, DH_B)
    w1_r = w1.reshape(r_n, S_CMP * DH_B, CMP_HID)
    z = 0.0
    for r in range(r_n):
        part = (P[:, r:r + nb] + pe_r[r][None, None, None]).reshape(bx, nb, G_B, S_CMP * DH_B)
        z = z + part @ w1_r[r]
    return jax.nn.silu(z) @ w2


def sel_overlap(nb, nsel):
    i = jnp.arange(nb)[:, None] * S_CMP
    j = jnp.arange(nsel)[None, :] * L_SEL
    return ((i <= j + L_SEL - 1) & (i + L_CMP - 1 >= j)).astype(jnp.float32)


def pad_to_sel(rows):
    L = rows.shape[1]
    nsel = -(-L // L_SEL)
    return jnp.pad(rows, ((0, 0), (0, nsel * L_SEL - L), (0, 0), (0, 0)))


def nsa_block(q, qpos, gates, kc, vc, cend, ks, vs, kw, vw, wpos):
    tq = q.shape[0]
    nb = kc.shape[0]
    nsel = ks.shape[0] // L_SEL
    slopes = alibi_slopes().reshape(G_B, HPG)[None, :, :, None]
    qg = q.reshape(tq, G_B, HPG, DH_B) * (DH_B ** -0.5)
    tpos = qpos[:, None, None, None]
    s = jnp.einsum('tghd,ngd->tghn', qg, kc).astype(jnp.float32) - slopes * (tpos - cend[None, None, None, :])
    ok = (cend[None, :] <= qpos[:, None])[:, None, None, :]
    p_cmp = masked_softmax(s, ok)
    o_cmp = jnp.einsum('tghn,ngd->tghd', p_cmp.astype(vc.dtype), vc)
    imp = jnp.einsum('tghn,nj->tgj', p_cmp, sel_overlap(nb, nsel))
    blk = jnp.arange(nsel)[None, :]
    cur = (qpos // L_SEL)[:, None]
    forced = (blk == 0) | (blk == cur) | (blk == cur - 1)
    score = jnp.where((blk <= cur)[:, None, :], imp + FORCE_BONUS * forced[:, None, :].astype(jnp.float32), -jnp.inf)
    _, sel = lax.top_k(score, min(N_SEL, nsel))
    g_idx = jnp.arange(G_B)[None, :, None]
    k_blk = ks.reshape(nsel, L_SEL, G_B, DH_B).transpose(2, 0, 1, 3)
    v_blk = vs.reshape(nsel, L_SEL, G_B, DH_B).transpose(2, 0, 1, 3)
    n_k = sel.shape[-1] * L_SEL
    k_sel = k_blk[g_idx, sel].reshape(tq, G_B, n_k, DH_B)
    v_sel = v_blk[g_idx, sel].reshape(tq, G_B, n_k, DH_B)
    spos = (sel[..., None] * L_SEL + jnp.arange(L_SEL)).reshape(tq, G_B, n_k)[:, :, None, :]
    s = jnp.einsum('tghd,tgsd->tghs', qg, k_sel).astype(jnp.float32) - slopes * (tpos - spos)
    p_slc = masked_softmax(s, spos <= tpos)
    o_slc = jnp.einsum('tghs,tgsd->tghd', p_slc.astype(v_sel.dtype), v_sel)
    dist = qpos[:, None] - wpos[None, :]
    okw = ((dist >= 0) & (dist <= WINDOW) & (wpos[None, :] >= 0))[:, None, None, :]
    s = jnp.einsum('tghd,sgd->tghs', qg, kw).astype(jnp.float32) - slopes * dist[:, None, None, :]
    p_win = masked_softmax(s, okw)
    o_win = jnp.einsum('tghs,sgd->tghd', p_win.astype(vw.dtype), vw)
    g = gates.reshape(tq, G_B, HPG, 3).astype(jnp.float32)
    out = g[..., 0:1] * o_cmp + g[..., 1:2] * o_slc + g[..., 2:3] * o_win
    return out.reshape(tq, H_B * DH_B).astype(q.dtype)


def nsa_prompt(q, gates, kc, vc, cend, ks, vs, kw, vw):
    nb_, t_ = q.shape[:2]
    nqb = t_ // Q_BLOCK
    pad = ((0, 0), (WINDOW, 0), (0, 0), (0, 0))
    kw_p = jnp.pad(kw, pad)
    vw_p = jnp.pad(vw, pad)
    span = WINDOW + Q_BLOCK

    def item(n):
        b = n // nqb
        s0 = (n % nqb) * Q_BLOCK
        qpos = s0 + jnp.arange(Q_BLOCK)
        wpos = s0 - WINDOW + jnp.arange(span)
        return nsa_block(lax.dynamic_slice_in_dim(q[b], s0, Q_BLOCK, 0), qpos,
                         lax.dynamic_slice_in_dim(gates[b], s0, Q_BLOCK, 0),
                         kc[b], vc[b], cend, ks[b], vs[b],
                         lax.dynamic_slice_in_dim(kw_p[b], s0, span, 0),
                         lax.dynamic_slice_in_dim(vw_p[b], s0, span, 0), wpos)

    o = lax.map(item, jnp.arange(nb_ * nqb))
    return o.reshape(nb_, t_, H_B * DH_B)


def nsa_sample(q, gates, kc, vc, cend, ks, vs, kw, vw, qpos, wpos):
    def item(b):
        return nsa_block(q[b], qpos, gates[b], kc[b], vc[b], cend, ks[b], vs[b], kw[b], vw[b], wpos)
    return lax.map(item, jnp.arange(q.shape[0]))


def trunk(x, c, S_ret, conv_buf, past_kv, win_buf, p, sample):
    b, t, _ = x.shape
    n_a = DEPTH // 2
    new_S, new_conv = [], []
    for l in range(DEPTH):
        mod = jax.nn.silu(c) @ p['w_ada'][l] + p['b_ada'][l]
        sh1, sc1, ga1, sh2, sc2, ga2 = jnp.split(mod, 6, axis=-1)
        if l == n_a:
            mkv = jax.nn.silu(c) @ p['w_ada_kv'] + p['b_ada_kv']
            sh_kv, sc_kv = jnp.split(mkv, 2, axis=-1)
            hk = modulate(rmsnorm(x, p['g_kv']), sh_kv, sc_kv)
            kv = (hk @ p['w_kv']).reshape(b, t, 6, G_B, DH_B)
            kv_rows, win_rows = kv[:, :, :4], kv[:, :, 4:]
            if sample:
                ctx = jnp.concatenate([past_kv.astype(kv.dtype), kv_rows], axis=1)
                win_ctx = jnp.concatenate([win_buf.astype(kv.dtype), win_rows], axis=1)
                past = past_kv.shape[1]
                qpos = past + jnp.arange(t)
                wpos = past - win_buf.shape[1] + jnp.arange(win_ctx.shape[1])
            else:
                ctx = kv_rows
                win_ctx = win_rows
            kc = compress_branch(ctx[:, :, 0], p['pe_ck'], p['w_ck1'], p['w_ck2'])
            vc = compress_branch(ctx[:, :, 1], p['pe_cv'], p['w_cv1'], p['w_cv2'])
            cend = jnp.arange(kc.shape[1]) * S_CMP + (L_CMP - 1)
            ks = pad_to_sel(ctx[:, :, 2])
            vs = pad_to_sel(ctx[:, :, 3])
            kw, vw = win_ctx[:, :, 0], win_ctx[:, :, 1]
            new_win = win_ctx[:, -min(WINDOW, win_ctx.shape[1]):]
        h = modulate(rmsnorm(x, p['g_mix'][l]), sh1, sc1)
        if l < n_a:
            y, S = retention_mixer(h, S_ret[l], p['w_ret_in'][l], p['w_ret_out'][l])
            new_S.append(S)
        else:
            lb = l - n_a
            pr = h @ p['w_nsa_in'][lb]
            q = pr[..., :H_B * DH_B].reshape(b, t, H_B, DH_B)
            gates = jax.nn.sigmoid(pr[..., H_B * DH_B:].astype(jnp.float32)).reshape(b, t, H_B, 3)
            if sample:
                o = nsa_sample(q, gates, kc, vc, cend, ks, vs, kw, vw, qpos, wpos)
            else:
                o = nsa_prompt(q, gates, kc, vc, cend, ks, vs, kw, vw)
            y = o @ p['w_nsa_out'][lb]
        x = x + ga1[:, None, :] * y
        h = modulate(rmsnorm(x, p['g_ffn'][l]), sh2, sc2)
        y, buf = conv_ffn(h, conv_buf[l], p['w_ffn_in'][l], p['conv_w'][l], p['conv_b'][l], p['w_ffn_out'][l])
        new_conv.append(buf)
        x = x + ga2[:, None, :] * y
    return rmsnorm(x, p['g_final']), jnp.stack(new_S), jnp.stack(new_conv), kv_rows, new_win


def setup_inputs(seed: int = 0) -> dict:
    key = jax.random.key(seed)
    kit = iter(list(jax.random.split(key, 40)))
    n_a = DEPTH // 2
    n_b = DEPTH - n_a
    n_pages = PAST_LEN // PAGE_SIZE
    n_used = DEC_BATCH * n_pages
    n_phys = n_used + max(1, n_used // 4)
    w_buf = min(WINDOW, PAST_LEN)
    d = D_MODEL
    f2 = 2 * D_FF
    ret_proj = H_A * (2 * DK_A + 2 * DV_A)

    def nrm(shape, scale):
        return jax.random.normal(next(kit), shape, jnp.float32) * scale

    x_prompt = nrm((BATCH, SEQ, d), 1.0)
    x_sample = nrm((DEC_BATCH, DEC_SEQ, d), 1.0)
    c_prompt = nrm((BATCH, d), 1.0)
    c_sample = nrm((DEC_BATCH, d), 1.0)
    state_ret = nrm((n_a, DEC_BATCH, H_A, DK_A, DV_A), 1.0)
    state_conv = nrm((DEPTH, DEC_BATCH, CONV_W - 1, f2), 1.0)
    cache_kv = nrm((n_phys, PAGE_SIZE, 4, G_B, DH_B), 1.0)
    state_win = nrm((DEC_BATCH, w_buf, 2, G_B, DH_B), 1.0)
    page_table = jax.random.permutation(next(kit), n_phys)[:n_used].reshape(DEC_BATCH, n_pages).astype(jnp.int32)
    return {
        'x_prompt': x_prompt, 'x_sample': x_sample, 'c_prompt': c_prompt, 'c_sample': c_sample,
        'state_ret': state_ret, 'state_conv': state_conv, 'cache_kv': cache_kv, 'state_win': state_win,
        'page_table': page_table,
        'w_ada': nrm((DEPTH, d, 6 * d), 0.5 * d ** -0.5),
        'b_ada': nrm((DEPTH, 6 * d), 0.02),
        'g_mix': 1.0 + nrm((DEPTH, d), 0.05),
        'g_ffn': 1.0 + nrm((DEPTH, d), 0.05),
        'w_ffn_in': nrm((DEPTH, d, f2), d ** -0.5),
        'conv_w': nrm((DEPTH, CONV_W, f2), CONV_W ** -0.5),
        'conv_b': nrm((DEPTH, f2), 0.02),
        'w_ffn_out': nrm((DEPTH, D_FF, d), D_FF ** -0.5),
        'w_ret_in': nrm((n_a, d, ret_proj), d ** -0.5),
        'w_ret_out': nrm((n_a, H_A * DV_A, d), (H_A * DV_A) ** -0.5),
        'g_kv': 1.0 + nrm((d,), 0.05),
        'w_ada_kv': nrm((d, 2 * d), 0.5 * d ** -0.5),
        'b_ada_kv': nrm((2 * d,), 0.02),
        'w_kv': nrm((d, 6 * G_B * DH_B), d ** -0.5),
        'pe_ck': nrm((L_CMP, DH_B), 0.1),
        'pe_cv': nrm((L_CMP, DH_B), 0.1),
        'w_ck1': nrm((L_CMP * DH_B, CMP_HID), (L_CMP * DH_B) ** -0.5),
        'w_ck2': nrm((CMP_HID, DH_B), CMP_HID ** -0.5),
        'w_cv1': nrm((L_CMP * DH_B, CMP_HID), (L_CMP * DH_B) ** -0.5),
        'w_cv2': nrm((CMP_HID, DH_B), CMP_HID ** -0.5),
        'w_nsa_in': nrm((n_b, d, H_B * DH_B + 3 * H_B), d ** -0.5),
        'w_nsa_out': nrm((n_b, H_B * DH_B, d), (H_B * DH_B) ** -0.5),
        'g_final': 1.0 + nrm((d,), 0.05),
    }


def reference(x_prompt, x_sample, c_prompt, c_sample, state_ret, state_conv, cache_kv, state_win, page_table,
              w_ada, b_ada, g_mix, g_ffn, w_ffn_in, conv_w, conv_b, w_ffn_out, w_ret_in, w_ret_out,
              g_kv, w_ada_kv, b_ada_kv, w_kv, pe_ck, pe_cv, w_ck1, w_ck2, w_cv1, w_cv2,
              w_nsa_in, w_nsa_out, g_final):
    p = dict(w_ada=w_ada, b_ada=b_ada, g_mix=g_mix, g_ffn=g_ffn, w_ffn_in=w_ffn_in, conv_w=conv_w,
             conv_b=conv_b, w_ffn_out=w_ffn_out, w_ret_in=w_ret_in, w_ret_out=w_ret_out, g_kv=g_kv,
             w_ada_kv=w_ada_kv, b_ada_kv=b_ada_kv, w_kv=w_kv, pe_ck=pe_ck, pe_cv=pe_cv, w_ck1=w_ck1,
             w_ck2=w_ck2, w_cv1=w_cv1, w_cv2=w_cv2, w_nsa_in=w_nsa_in, w_nsa_out=w_nsa_out, g_final=g_final)
    n_a = DEPTH // 2
    bp = x_prompt.shape[0]
    db = x_sample.shape[0]
    past = page_table.shape[1] * PAGE_SIZE
    past_kv = cache_kv[page_table].reshape(db, past, 4, G_B, DH_B)
    S0_p = jnp.zeros((n_a, bp, H_A, DK_A, DV_A), jnp.float32)
    conv0_p = jnp.zeros((DEPTH, bp, CONV_W - 1, 2 * D_FF), x_prompt.dtype)
    y_prompt, ret_prompt, conv_prompt, kv_prompt, win_prompt = trunk(
        x_prompt, c_prompt, S0_p, conv0_p, None, None, p, False)
    y_sample, ret_sample, conv_sample, kv_sample, win_sample = trunk(
        x_sample, c_sample, state_ret.astype(jnp.float32), state_conv, past_kv, state_win, p, True)
    return (y_prompt, y_sample, ret_prompt, ret_sample, conv_prompt, conv_sample,
            kv_prompt, kv_sample, win_prompt, win_sample)
```

```cpp
#ifndef EMU
#include <hip/hip_runtime.h>
#include <cstdio>
#include <cstdint>
#endif

#ifndef CFG_BATCH
#define CFG_BATCH 8
#endif
#ifndef CFG_SEQ
#define CFG_SEQ 2048
#endif
#ifndef CFG_DB
#define CFG_DB 128
#endif
#ifndef CFG_PAST
#define CFG_PAST 2048
#endif
#ifndef CFG_NSEL
#define CFG_NSEL 16
#endif
#ifndef CFG_WINDOW
#define CFG_WINDOW 512
#endif
#ifndef CFG_DFF
#define CFG_DFF 2816
#endif
constexpr int BATCH = CFG_BATCH, SEQ = CFG_SEQ, DB = CFG_DB, PAST = CFG_PAST, NSEL = CFG_NSEL, WINDOW = CFG_WINDOW, DFF = CFG_DFF;
constexpr int D = 1024, DS = 8, PAGE = 128, NPAGES = PAST / PAGE;
constexpr int HA = 4, DK = 256, DV = 512, CH = 128, NQ = HA * DK, NV = HA * DV, RETP = 2 * NQ + 2 * NV;
constexpr int HB = 16, DH = 64, GB = 4, HPG = 4, F2 = 2 * DFF;
constexpr int TP = BATCH * SEQ, TS = DB * DS, TT = TP + TS, NBAT = BATCH + DB;
constexpr int NKV = 6 * GB * DH;
constexpr int NNSA = HB * DH + 3 * HB;
constexpr int NNSA_PAD = 1152;
constexpr int NPC_P = SEQ / 16, NPC_S = PAST / 16, NCB_P = NPC_P - 1, NCB_S = NPC_S - 1;
constexpr int NCBS = 128;
constexpr int CROWS_P = BATCH * NPC_P * 4, CROWS_S = DB * NPC_S * 4, CROWS = CROWS_P + CROWS_S;
constexpr int WBUF = (WINDOW < PAST ? WINDOW : PAST);
constexpr int WINP = (WINDOW < SEQ ? WINDOW : SEQ);
constexpr int WINS = (WINDOW < WBUF + DS ? WINDOW : WBUF + DS);
constexpr int NSELB_P = SEQ / 64;
constexpr int NSELB_S = (PAST + DS + 63) / 64;
constexpr int MODN = 14 * D;
static_assert(SEQ % 128 == 0 && PAST % 128 == 0 && NPC_P <= 128 && NPC_S <= 128 && NSELB_P <= 32 && NSELB_S <= 33 && DFF % 64 == 0, "cfg");

typedef unsigned short bf16_t;
typedef short bf16x8 __attribute__((ext_vector_type(8)));
typedef short bf16x4 __attribute__((ext_vector_type(4)));
typedef float f32x4 __attribute__((ext_vector_type(4)));
typedef float f32x2 __attribute__((ext_vector_type(2)));
typedef unsigned u32x4 __attribute__((ext_vector_type(4)));
typedef unsigned u32x2 __attribute__((ext_vector_type(2)));
#define DI __device__ __forceinline__

#ifdef EMU
#define MFMA16(a, b, c) emu_mfma_16x16x32_bf16((a), (b), (c))
#define LAUNCH(kern, grid, block, lds, stream, ...) emu_launch(dim3(grid), dim3(block), lds, [=]() { kern(__VA_ARGS__); })
#define WAVE_SYNC() (void)__ballot(1)
#define OPAQUE(x) ((void)0)
#define UNIFORM(x) (x)
DI char* lds_base() { return (char*)emu_cur->blk->lds; }
#else
#define MFMA16(a, b, c) __builtin_amdgcn_mfma_f32_16x16x32_bf16((a), (b), (c), 0, 0, 0)
#define LAUNCH(kern, grid, block, lds, stream, ...) hipLaunchKernelGGL(kern, dim3(grid), dim3(block), lds, stream, __VA_ARGS__)
#define WAVE_SYNC() do { asm volatile("s_waitcnt lgkmcnt(0)" ::: "memory"); __builtin_amdgcn_wave_barrier(); asm volatile("" ::: "memory"); } while (0)
#define OPAQUE(x) asm volatile("" : "+v"(x))
#define UNIFORM(x) __builtin_amdgcn_readfirstlane(x)
extern __shared__ __attribute__((aligned(16))) char dyn_lds_[];
DI char* lds_base() { return dyn_lds_; }
#endif

DI bf16_t f2bf(float x) { unsigned u = __float_as_uint(x); u += 0x7fffu + ((u >> 16) & 1u); return (bf16_t)(u >> 16); }
DI float bf2f(bf16_t h) { return __uint_as_float(((unsigned)h) << 16); }
DI unsigned pack2(float lo, float hi) { return (unsigned)f2bf(lo) | ((unsigned)f2bf(hi) << 16); }
DI bf16x4 pack4(f32x4 v) { u32x2 r; r.x = pack2(v.x, v.y); r.y = pack2(v.z, v.w); return __builtin_bit_cast(bf16x4, r); }
DI bf16x8 pack8(f32x4 a, f32x4 b) { u32x4 r; r.x = pack2(a.x, a.y); r.y = pack2(a.z, a.w); r.z = pack2(b.x, b.y); r.w = pack2(b.z, b.w); return __builtin_bit_cast(bf16x8, r); }
DI bf16x8 cat4(bf16x4 a, bf16x4 b) { return __builtin_shufflevector(a, b, 0, 1, 2, 3, 4, 5, 6, 7); }
DI float siluf(float x) { return x / (1.0f + __expf(-x)); }
DI float sigmoidf(float x) { return 1.0f / (1.0f + __expf(-x)); }
DI float wave_sum(float v) { v += __shfl_xor(v, 1); v += __shfl_xor(v, 2); v += __shfl_xor(v, 4); v += __shfl_xor(v, 8); v += __shfl_xor(v, 16); v += __shfl_xor(v, 32); return v; }
DI float wave_max(float v) { v = fmaxf(v, __shfl_xor(v, 1)); v = fmaxf(v, __shfl_xor(v, 2)); v = fmaxf(v, __shfl_xor(v, 4)); v = fmaxf(v, __shfl_xor(v, 8)); v = fmaxf(v, __shfl_xor(v, 16)); v = fmaxf(v, __shfl_xor(v, 32)); return v; }

#ifdef EMU
struct XcdBarrier { int dummy; };
#define XCD_BAR_WORDS 3456
DI void grid_barrier(const XcdBarrier&) { emu_grid_barrier(); }
#else
#define XB_TMO      128
#define XB_XCNT(j)  (256  + 64 * (j))
#define XB_XSUB(j)  (1280 + 64 * (j))
#define XB_XGEN(j)  (2304 + 64 * (j))
#define XB_TOP      3328
#define XB_TOPGEN   3392
#define XCD_BAR_WORDS 3456
#define XB_SPIN_CAP (1u << 22)
#define LAS __attribute__((address_space(3)))
__device__ __forceinline__ unsigned xb_ld(unsigned* p)              { return __hip_atomic_load(p, __ATOMIC_RELAXED, __HIP_MEMORY_SCOPE_AGENT); }
__device__ __forceinline__ unsigned xb_add(unsigned* p, unsigned v) { return __hip_atomic_fetch_add(p, v, __ATOMIC_RELAXED, __HIP_MEMORY_SCOPE_AGENT); }
__device__ __forceinline__ unsigned xb_xcc_id() { return (unsigned)__builtin_amdgcn_s_getreg((3 << 11) | 20) & 0xFu; }
#define XB_SPIN(cond, bar) do { unsigned _sp = 0; while (cond) { __builtin_amdgcn_s_sleep(1); \
    if ((++_sp & 255u) == 0u) { if (xb_ld(&(bar)[XB_TMO])) break; if (_sp > XB_SPIN_CAP) { atomicAdd(&(bar)[XB_TMO], 1u); break; } } } } while (0)
struct XcdBarrier { unsigned* bar; unsigned x; volatile LAS unsigned* st; };
__device__ __forceinline__ XcdBarrier xcd_barrier_post(unsigned* bar, volatile LAS unsigned* st) {
    XcdBarrier b; b.bar = bar; b.x = xb_xcc_id(); b.st = st;
    if (threadIdx.x == 0) (void)xb_add(&bar[XB_XCNT(b.x)], 1u);
    return b;
}
__device__ __forceinline__ void xcd_barrier_complete(unsigned* bar, unsigned x, unsigned& nloc, unsigned& nx) {
    const unsigned G = gridDim.x * gridDim.y * gridDim.z;
    unsigned sum, cnt, mine, sp = 0u;
    for (;;) {
        sum = 0u; cnt = 0u; mine = 0u;
#pragma unroll
        for (unsigned j = 0; j < 16; ++j) { const unsigned c = xb_ld(&bar[XB_XCNT(j)]); sum += c; cnt += (c > 0u) ? 1u : 0u; mine = (j == x) ? c : mine; }
        if (sum == G) break;
        __builtin_amdgcn_s_sleep(1);
        if ((++sp & 255u) == 0u) { if (xb_ld(&bar[XB_TMO])) break; if (sp > XB_SPIN_CAP) { atomicAdd(&bar[XB_TMO], 1u); break; } }
    }
    nloc = mine > 0u ? mine : 1u; nx = cnt > 0u ? cnt : 1u;
}
__device__ __forceinline__ void xcd_barrier(const XcdBarrier& b) {
    asm volatile("s_waitcnt vmcnt(0)" ::: "memory");
    __syncthreads();
    if (threadIdx.x == 0) {
        unsigned* bar = b.bar;
        __builtin_amdgcn_s_waitcnt(0);
        unsigned nloc = b.st[0], nx = b.st[1];
        if (nloc == 0u) { xcd_barrier_complete(bar, b.x, nloc, nx); b.st[0] = nloc; b.st[1] = nx; }
        const unsigned old = xb_add(&bar[XB_XSUB(b.x)], 1u);
        const unsigned gen = old / nloc;
        if (old + 1u == (gen + 1u) * nloc) {
            __builtin_amdgcn_fence(__ATOMIC_RELEASE, "agent");
            asm volatile("s_waitcnt vmcnt(0)" ::: "memory");
            const unsigned og = xb_add(&bar[XB_TOP], 1u);
            const unsigned tg = og / nx;
            if (og + 1u == (tg + 1u) * nx) xb_add(&bar[XB_TOPGEN], 1u);
            else XB_SPIN(xb_ld(&bar[XB_TOPGEN]) == tg, bar);
            __builtin_amdgcn_fence(__ATOMIC_ACQUIRE, "agent");
            xb_add(&bar[XB_XGEN(b.x)], 1u);
            asm volatile("s_waitcnt vmcnt(0)" ::: "memory");
        } else {
            XB_SPIN(xb_ld(&bar[XB_XGEN(b.x)]) == gen, bar);
            __builtin_amdgcn_fence(__ATOMIC_ACQUIRE, "agent");
            asm volatile("s_waitcnt vmcnt(0)" ::: "memory");
        }
    }
    __syncthreads();
}
DI void grid_barrier(const XcdBarrier& b) { xcd_barrier(b); }
#endif

struct Params {
    const float *x_prompt, *x_sample, *c_prompt, *c_sample, *state_ret, *state_conv, *cache_kv, *state_win;
    const int* page_table;
    const float *w_ada, *b_ada, *g_mix, *g_ffn, *w_ffn_in, *conv_w, *conv_b, *w_ffn_out, *w_ret_in, *w_ret_out, *g_kv, *w_ada_kv, *b_ada_kv, *w_kv,
        *pe_ck, *pe_cv, *w_ck1, *w_ck2, *w_cv1, *w_cv2, *w_nsa_in, *w_nsa_out, *g_final;
    float *y_prompt, *y_sample, *ret_prompt, *ret_sample, *conv_prompt, *conv_sample, *kv_prompt, *kv_sample, *win_prompt, *win_sample;
    unsigned* bar;
    bf16_t *Wada, *Wret_in, *Wret_out, *Wffn_in, *Wffn_out, *Wkv, *Wnsa_in, *Wnsa_out, *Wc1, *Wc2;
    float *cbias, *mod, *X, *ssq, *gates, *Z1;
    bf16_t *scb, *hbuf, *hkv, *qb, *kb, *vb, *sgb, *kT, *vT, *obuf, *actr, *u, *actf, *kvb, *vTs, *vTw, *kc, *vcT, *ao;
    int ph_lo, ph_hi;
};

struct WsAlloc { size_t off = 0; template <class T> T* take(void* base, size_t n) { T* p = (T*)((char*)base + off); off += (n * sizeof(T) + 255) & ~(size_t)255; return p; } };

constexpr int GBM = 256, GBN = 128, GBK = 64, GPITCH = 72;
constexpr int GEMM_LDS = (GBM + GBN) * GPITCH * 2;
struct LoadRowMajor { const bf16_t* A; int lda; DI bf16x8 operator()(int row, int k0) const { return *(const bf16x8*)(A + (size_t)row * lda + k0); } };

template <bool TRANS, class LoadA, class Epi>
DI void gemm_phase(int M, int N, int K, const bf16_t* __restrict__ Bt, const LoadA& loadA, const Epi& epi, char* lds) {
    bf16_t* As = (bf16_t*)lds; bf16_t* Bs = As + GBM * GPITCH;
    const int tid = threadIdx.x, lane = tid & 63, w = tid >> 6, wm = w >> 1, wn = w & 1, l15 = lane & 15, q = lane >> 4;
    const int nM = (M + GBM - 1) / GBM, nN = N / GBN, nK = K / GBK;
    for (int tile = blockIdx.x; tile < nM * nN; tile += gridDim.x) {
        const int tm = tile / nN, tn = tile % nN;
        const int arow0 = tm * GBM, brow0 = tn * GBN;
        f32x4 acc[4][4];
#pragma unroll
        for (int i = 0; i < 4; ++i)
#pragma unroll
            for (int j = 0; j < 4; ++j) acc[i][j] = (f32x4){0.f, 0.f, 0.f, 0.f};
        bf16x8 pa[4], pb[2];
        int ar[4], ak[4];
#pragma unroll
        for (int i = 0; i < 4; ++i) { const int c = tid + 512 * i; ar[i] = c >> 3; ak[i] = (c & 7) * 8; }
#pragma unroll
        for (int i = 0; i < 4; ++i) { int r = arow0 + ar[i]; r = r < M ? r : M - 1; pa[i] = loadA(r, ak[i]); }
#pragma unroll
        for (int i = 0; i < 2; ++i) pb[i] = *(const bf16x8*)(Bt + (size_t)(brow0 + ar[i]) * K + ak[i]);
        for (int kt = 0; kt < nK; ++kt) {
            __syncthreads();
#pragma unroll
            for (int i = 0; i < 4; ++i) *(bf16x8*)(As + ar[i] * GPITCH + ak[i]) = pa[i];
#pragma unroll
            for (int i = 0; i < 2; ++i) *(bf16x8*)(Bs + ar[i] * GPITCH + ak[i]) = pb[i];
            __syncthreads();
            if (kt + 1 < nK) {
                const int k0 = (kt + 1) * GBK;
#pragma unroll
                for (int i = 0; i < 4; ++i) { int r = arow0 + ar[i]; r = r < M ? r : M - 1; pa[i] = loadA(r, k0 + ak[i]); }
#pragma unroll
                for (int i = 0; i < 2; ++i) pb[i] = *(const bf16x8*)(Bt + (size_t)(brow0 + ar[i]) * K + k0 + ak[i]);
            }
#pragma unroll
            for (int ks = 0; ks < 2; ++ks) {
                bf16x8 a[4], b[4];
#pragma unroll
                for (int i = 0; i < 4; ++i) a[i] = *(const bf16x8*)(As + (wm * 64 + i * 16 + l15) * GPITCH + ks * 32 + q * 8);
#pragma unroll
                for (int j = 0; j < 4; ++j) b[j] = *(const bf16x8*)(Bs + (wn * 64 + j * 16 + l15) * GPITCH + ks * 32 + q * 8);
#pragma unroll
                for (int i = 0; i < 4; ++i)
#pragma unroll
                    for (int j = 0; j < 4; ++j) acc[i][j] = TRANS ? MFMA16(b[j], a[i], acc[i][j]) : MFMA16(a[i], b[j], acc[i][j]);
            }
        }
#pragma unroll
        for (int i = 0; i < 4; ++i)
#pragma unroll
            for (int j = 0; j < 4; ++j) {
                if (TRANS) { const int m = arow0 + wm * 64 + i * 16 + l15, n = brow0 + wn * 64 + j * 16 + 4 * q; if (m < M) epi(m, n, acc[i][j]); }
                else { const int m = arow0 + wm * 64 + i * 16 + 4 * q, n = brow0 + wn * 64 + j * 16 + l15; if (m < M) epi(m, n, acc[i][j]); }
            }
    }
}

DI int tok_batch(int tok) { return tok < TP ? tok / SEQ : BATCH + (tok - TP) / DS; }
DI const float* x_in_row(const Params& p, int tok) { return tok < TP ? p.x_prompt + (size_t)tok * D : p.x_sample + (size_t)(tok - TP) * D; }

struct CvtJob { const float* src; bf16_t* dst; int K, N, ld; float scale; int slo, shi; };
constexpr int NCVT = 16;
DI CvtJob cvt_job(const Params& p, int j) {
    CvtJob c; c.scale = 1.f; c.slo = 0; c.shi = 0;
    switch (j) {
    case 0:  c = {p.w_ada, p.Wada, D, 6 * D, 6 * D, 1.f, 0, 0}; break;
    case 1:  c = {p.w_ada + (size_t)D * 6 * D, p.Wada + (size_t)6 * D * D, D, 6 * D, 6 * D, 1.f, 0, 0}; break;
    case 2:  c = {p.w_ada_kv, p.Wada + (size_t)12 * D * D, D, 2 * D, 2 * D, 1.f, 0, 0}; break;
    case 3:  c = {p.w_ret_in, p.Wret_in, D, RETP, RETP, 0.0625f, NQ, 2 * NQ}; break;
    case 4:  c = {p.w_ret_out, p.Wret_out, NV, D, D, 1.f, 0, 0}; break;
    case 5:  c = {p.w_ffn_in, p.Wffn_in, D, F2, F2, 1.f, 0, 0}; break;
    case 6:  c = {p.w_ffn_in + (size_t)D * F2, p.Wffn_in + (size_t)F2 * D, D, F2, F2, 1.f, 0, 0}; break;
    case 7:  c = {p.w_ffn_out, p.Wffn_out, DFF, D, D, 1.f, 0, 0}; break;
    case 8:  c = {p.w_ffn_out + (size_t)DFF * D, p.Wffn_out + (size_t)D * DFF, DFF, D, D, 1.f, 0, 0}; break;
    case 9:  c = {p.w_kv, p.Wkv, D, NKV, NKV, 1.f, 0, 0}; break;
    case 10: c = {p.w_nsa_in, p.Wnsa_in, D, NNSA, NNSA, 0.125f, 0, HB * DH}; break;
    case 11: c = {p.w_nsa_out, p.Wnsa_out, D, D, D, 1.f, 0, 0}; break;
    case 12: c = {p.w_ck1, p.Wc1, 1024, 128, 128, 1.f, 0, 0}; break;
    case 13: c = {p.w_ck1 + 1024 * 128, p.Wc1 + 128 * 1024, 1024, 128, 128, 1.f, 0, 0}; break;
    case 14: c = {p.w_cv1, p.Wc1 + 256 * 1024, 1024, 128, 128, 1.f, 0, 0}; break;
    default: c = {p.w_cv1 + 1024 * 128, p.Wc1 + 384 * 1024, 1024, 128, 128, 1.f, 0, 0}; break;
    }
    return c;
}
DI void phase_prologue(const Params& p, char* lds) {
    float* tl = (float*)lds;
    const int tid = threadIdx.x;
    int total = 0;
    for (int j = 0; j < NCVT; ++j) { const CvtJob c = cvt_job(p, j); total += (c.K / 64) * ((c.N + 63) / 64); }
    for (int t = blockIdx.x; t < total; t += gridDim.x) {
        int j = 0, rem = t; CvtJob c = cvt_job(p, 0);
        for (;; ++j) { c = cvt_job(p, j); const int n = (c.K / 64) * ((c.N + 63) / 64); if (rem < n) break; rem -= n; }
        const int nkt = c.K / 64, tk = rem % nkt, tnn = rem / nkt, k0 = tk * 64, n0 = tnn * 64;
        __syncthreads();
#pragma unroll
        for (int i = 0; i < 2; ++i) {
            const int r = (tid >> 4) + 32 * i, c4 = (tid & 15) * 4;
            f32x4 v = (f32x4){0.f, 0.f, 0.f, 0.f};
            if (n0 + c4 + 3 < c.N) v = *(const f32x4*)(c.src + (size_t)(k0 + r) * c.ld + n0 + c4);
            else { for (int e = 0; e < 4; ++e) if (n0 + c4 + e < c.N) v[e] = c.src[(size_t)(k0 + r) * c.ld + n0 + c4 + e]; }
            for (int e = 0; e < 4; ++e) tl[r * 65 + c4 + e] = v[e];
        }
        __syncthreads();
        const int nr = tid >> 3, kc = (tid & 7) * 8, n = n0 + nr;
        if (n < c.N) {
            const float s = (n >= c.slo && n < c.shi) ? c.scale : 1.f;
            f32x4 a, b;
            for (int e = 0; e < 4; ++e) { a[e] = tl[(kc + e) * 65 + nr] * s; b[e] = tl[(kc + 4 + e) * 65 + nr] * s; }
            *(bf16x8*)(c.dst + (size_t)n * c.K + k0 + kc) = pack8(a, b);
        }
    }
    const int gtid = blockIdx.x * 512 + tid, gn = gridDim.x * 512;
    for (int i = gtid; i < (NNSA_PAD - NNSA) * D / 8; i += gn) *(bf16x8*)(p.Wnsa_in + (size_t)NNSA * D + (size_t)i * 8) = (bf16x8){0, 0, 0, 0, 0, 0, 0, 0};
    for (int i = gtid; i < 2 * 128 * 128; i += gn) { const int c = i >> 14, n = (i >> 7) & 127, k = i & 127; const float* w2 = c ? p.w_cv2 : p.w_ck2; p.Wc2[i] = n < 64 ? f2bf(w2[k * 64 + n]) : (bf16_t)0; }
    for (int i = gtid; i < 256 * D; i += gn) { const int r = i >> 10, k = i & 1023; float v = 0.f; if (r < BATCH) v = siluf(p.c_prompt[r * D + k]); else if (r < NBAT) v = siluf(p.c_sample[(r - BATCH) * D + k]); p.scb[i] = f2bf(v); }
    for (int i = gtid; i < NBAT * NCBS * 256 / 8; i += gn) { ((bf16x8*)p.kc)[i] = (bf16x8){0, 0, 0, 0, 0, 0, 0, 0}; ((bf16x8*)p.vcT)[i] = (bf16x8){0, 0, 0, 0, 0, 0, 0, 0}; }
    for (size_t i = gtid; i < (size_t)DB * (WINS - DS) * 128; i += gn) { const size_t b = i / ((size_t)(WINS - DS) * 128), r = i % ((size_t)(WINS - DS) * 128);
        *(f32x4*)(p.win_sample + b * WINS * 512 + r * 4) = *(const f32x4*)(p.state_win + b * WBUF * 512 + (size_t)(WBUF + DS - WINS) * 512 + r * 4); }
    for (int i = gtid; i < 256; i += gn) { const int c = i >> 7, n = i & 127; const float* pe = c ? p.pe_cv : p.pe_ck; const float* w1 = c ? p.w_cv1 : p.w_ck1; float s = 0.f; for (int k = 0; k < 2048; ++k) s += pe[k] * w1[(size_t)k * 128 + n]; p.cbias[i] = s; }
}

template <bool TWO>
DI void phase_normmod(const Params& p, bool from_input, const float* g1, int sh1, int sc1, bf16_t* dst1, const float* g2, int sh2, int sc2, bf16_t* dst2) {
    const int lane = threadIdx.x & 63, gw = blockIdx.x * 8 + (threadIdx.x >> 6), nw = gridDim.x * 8;
    for (int tok = gw; tok < TT; tok += nw) {
        const float* xr = from_input ? x_in_row(p, tok) : p.X + (size_t)tok * D;
        const float* mrow = p.mod + (size_t)tok_batch(tok) * MODN;
        f32x4 v[4]; float ss = 0.f;
#pragma unroll
        for (int i = 0; i < 4; ++i) { v[i] = *(const f32x4*)(xr + i * 256 + lane * 4); ss += v[i].x * v[i].x + v[i].y * v[i].y + v[i].z * v[i].z + v[i].w * v[i].w; }
        ss = wave_sum(ss);
        const float rstd = 1.0f / sqrtf(ss * (1.0f / D) + 1e-6f);
#pragma unroll
        for (int i = 0; i < 4; ++i) {
            const int c = i * 256 + lane * 4;
            const f32x4 g = *(const f32x4*)(g1 + c), sh = *(const f32x4*)(mrow + sh1 + c), sc = *(const f32x4*)(mrow + sc1 + c);
            f32x4 o; for (int e = 0; e < 4; ++e) o[e] = v[i][e] * rstd * g[e] * (1.f + sc[e]) + sh[e];
            *(bf16x4*)(dst1 + (size_t)tok * D + c) = pack4(o);
            if (TWO) {
                const f32x4 gg = *(const f32x4*)(g2 + c), sh_ = *(const f32x4*)(mrow + sh2 + c), sc_ = *(const f32x4*)(mrow + sc2 + c);
                f32x4 o2; for (int e = 0; e < 4; ++e) o2[e] = v[i][e] * rstd * gg[e] * (1.f + sc_[e]) + sh_[e];
                *(bf16x4*)(dst2 + (size_t)tok * D + c) = pack4(o2);
            }
        }
    }
}
DI void phase_final_norm(const Params& p) {
    const int lane = threadIdx.x & 63, gw = blockIdx.x * 8 + (threadIdx.x >> 6), nw = gridDim.x * 8;
    for (int tok = gw; tok < TT; tok += nw) {
        const float* xr = p.X + (size_t)tok * D;
        float* yr = tok < TP ? p.y_prompt + (size_t)tok * D : p.y_sample + (size_t)(tok - TP) * D;
        f32x4 v[4]; float ss = 0.f;
#pragma unroll
        for (int i = 0; i < 4; ++i) { v[i] = *(const f32x4*)(xr + i * 256 + lane * 4); ss += v[i].x * v[i].x + v[i].y * v[i].y + v[i].z * v[i].z + v[i].w * v[i].w; }
        ss = wave_sum(ss);
        const float rstd = 1.0f / sqrtf(ss * (1.0f / D) + 1e-6f);
#pragma unroll
        for (int i = 0; i < 4; ++i) { const int c = i * 256 + lane * 4; const f32x4 g = *(const f32x4*)(p.g_final + c); f32x4 o; for (int e = 0; e < 4; ++e) o[e] = v[i][e] * rstd * g[e]; *(f32x4*)(yr + c) = o; }
    }
}

struct EpiAda {
    float* mod; const float *b_ada, *b_ada_kv;
    DI void operator()(int m, int n, f32x4 v) const {
        if (m >= NBAT) return;
        const float* b = n < 12 * D ? b_ada + n : b_ada_kv + (n - 12 * D);
        const f32x4 bv = *(const f32x4*)b;
        *(f32x4*)(mod + (size_t)m * MODN + n) = v + bv;
    }
};
DI float ret_gamma_log2(int h) { return log2f(1.0f - exp2f(-5.0f - (float)h)); }
struct EpiRetIn {
    bf16_t *qb, *kb, *vb, *sgb, *kT, *vT;
    DI void operator()(int m, int n, f32x4 v) const {
        const int i = m < TP ? (m % SEQ) % CH : (m - TP) % DS;
        if (n < NQ) { const float f = exp2f(ret_gamma_log2(n >> 8) * (float)i); *(bf16x4*)(qb + (size_t)m * NQ + n) = pack4(v * f); }
        else if (n < 2 * NQ) {
            const int c = n - NQ, h = c >> 8; const float f = exp2f(-ret_gamma_log2(h) * (float)i); const f32x4 kv = v * f;
            *(bf16x4*)(kb + (size_t)m * NQ + c) = pack4(kv);
            if (m < TP) { const int b = m / SEQ, t = m % SEQ; for (int e = 0; e < 4; ++e) kT[((size_t)(b * HA + h) * DK + (c & 255) + e) * SEQ + t] = f2bf(kv[e]); }
        } else if (n < 2 * NQ + NV) {
            const int c = n - 2 * NQ;
            *(bf16x4*)(vb + (size_t)m * NV + c) = pack4(v);
            if (m < TP) { const int b = m / SEQ, t = m % SEQ; for (int e = 0; e < 4; ++e) vT[((size_t)b * NV + c + e) * SEQ + t] = f2bf(v[e]); }
        } else { const int c = n - 2 * NQ - NV; f32x4 s; for (int e = 0; e < 4; ++e) s[e] = siluf(v[e]); *(bf16x4*)(sgb + (size_t)m * NV + c) = pack4(s); }
    }
};
struct EpiResid {
    const Params* p; bool from_input; int gate_off;
    DI void operator()(int m, int n, f32x4 v) const {
        const float* xr = from_input ? x_in_row(*p, m) : p->X + (size_t)m * D;
        const f32x4 x = *(const f32x4*)(xr + n), g = *(const f32x4*)(p->mod + (size_t)tok_batch(m) * MODN + gate_off + n);
        *(f32x4*)(p->X + (size_t)m * D + n) = x + g * v;
    }
};
struct EpiFfnIn {
    bf16_t* u; float *conv_p, *conv_s;
    DI void operator()(int m, int n, f32x4 v) const {
        *(bf16x4*)(u + (size_t)m * F2 + n) = pack4(v);
        if (m < TP) { const int b = m / SEQ, t = m % SEQ; if (t >= SEQ - 2) *(f32x4*)(conv_p + ((size_t)b * 2 + (t - (SEQ - 2))) * F2 + n) = v; }
        else { const int b = (m - TP) / DS, t = (m - TP) % DS; if (t >= DS - 2) *(f32x4*)(conv_s + ((size_t)b * 2 + (t - (DS - 2))) * F2 + n) = v; }
    }
};
struct EpiKv {
    const Params* p;
    DI void operator()(int m, int n, f32x4 v) const {
        const Params& P = *p;
        if (m < TP) {
            const int b = m / SEQ, t = m % SEQ;
            *(bf16x4*)(P.kvb + (size_t)m * NKV + n) = pack4(v);
            if (n < 1024) *(f32x4*)(P.kv_prompt + (size_t)m * 1024 + n) = v;
            else if (t >= SEQ - WINP) *(f32x4*)(P.win_prompt + ((size_t)b * WINP + (t - (SEQ - WINP))) * 512 + (n - 1024)) = v;
            if (n >= 768 && n < 1024) { for (int e = 0; e < 4; ++e) P.vTs[((size_t)b * 256 + (n - 768) + e) * SEQ + t] = f2bf(v[e]); }
            if (n >= 1280) { for (int e = 0; e < 4; ++e) P.vTw[((size_t)b * 256 + (n - 1280) + e) * SEQ + t] = f2bf(v[e]); }
        } else {
            const int b = (m - TP) / DS, t = (m - TP) % DS;
            if (n < 1024) *(f32x4*)(P.kv_sample + (size_t)(m - TP) * 1024 + n) = v;
            else *(f32x4*)(P.win_sample + ((size_t)b * WINS + (WINS - DS + t)) * 512 + (n - 1024)) = v;
        }
    }
};
struct EpiNsaIn {
    bf16_t* qb; float* gates;
    DI void operator()(int m, int n, f32x4 v) const {
        if (n < HB * DH) *(bf16x4*)(qb + (size_t)m * (HB * DH) + n) = pack4(v);
        else if (n < NNSA) { f32x4 s; for (int e = 0; e < 4; ++e) s[e] = sigmoidf(v[e]); *(f32x4*)(gates + (size_t)m * 48 + (n - HB * DH)) = s; }
    }
};
struct LoadCmp {
    const Params* p; int c;
    DI bf16x8 operator()(int r, int k0) const {
        const Params& P = *p; const int s = k0 >> 6, d0 = k0 & 63;
        if (r < CROWS_P) { const int g = r & 3, j = (r >> 2) % NPC_P, b = (r >> 2) / NPC_P; return *(const bf16x8*)(P.kvb + (size_t)(b * SEQ + 16 * j + s) * NKV + c * 256 + g * 64 + d0); }
        const int rr = r - CROWS_P, g = rr & 3, j = (rr >> 2) % NPC_S, b = (rr >> 2) / NPC_S, pos = 16 * j + s;
        const int page = P.page_table[b * NPAGES + (pos >> 7)];
        const float* src = P.cache_kv + ((size_t)page * PAGE + (pos & 127)) * 1024 + c * 256 + g * 64 + d0;
        return pack8(*(const f32x4*)src, *(const f32x4*)(src + 4));
    }
};
struct EpiZ1 { float* Z1; DI void operator()(int m, int n, f32x4 v) const { *(f32x4*)(Z1 + (size_t)m * 256 + n) = v; } };
struct LoadCmp2 {
    const float* Z1; const float* bias;
    DI bf16x8 operator()(int r, int k0) const {
        const int npc = r < CROWS_P ? NPC_P : NPC_S; const int i = ((r < CROWS_P ? r : r - CROWS_P) >> 2) % npc;
        const int r2 = (i + 1 < npc) ? r + 4 : r;
        f32x4 a = *(const f32x4*)(Z1 + (size_t)r * 256 + k0), b = *(const f32x4*)(Z1 + (size_t)r * 256 + k0 + 4);
        const f32x4 a2 = *(const f32x4*)(Z1 + (size_t)r2 * 256 + 128 + k0), b2 = *(const f32x4*)(Z1 + (size_t)r2 * 256 + 128 + k0 + 4);
        const f32x4 c0 = *(const f32x4*)(bias + k0), c1 = *(const f32x4*)(bias + k0 + 4);
        for (int e = 0; e < 4; ++e) { a[e] = siluf(a[e] + a2[e] + c0[e]); b[e] = siluf(b[e] + b2[e] + c1[e]); }
        return pack8(a, b);
    }
};
struct EpiCmp2 {
    bf16_t* kc; bf16_t* vcT; int c;
    DI void operator()(int m, int n, f32x4 v) const {
        if (n >= 64) return;
        int bb, i, g;
        if (m < CROWS_P) { g = m & 3; i = (m >> 2) % NPC_P; bb = (m >> 2) / NPC_P; if (i >= NCB_P) v = (f32x4){0.f, 0.f, 0.f, 0.f}; }
        else { const int rr = m - CROWS_P; g = rr & 3; i = (rr >> 2) % NPC_S; bb = BATCH + (rr >> 2) / NPC_S; if (i >= NCB_S) v = (f32x4){0.f, 0.f, 0.f, 0.f}; }
        if (c == 0) *(bf16x4*)(kc + ((size_t)(bb * NCBS + i) * 4 + g) * 64 + n) = pack4(v);
        else { for (int e = 0; e < 4; ++e) vcT[((size_t)(bb * 4 + g) * 64 + n + e) * NCBS + i] = f2bf(v[e]); }
    }
};

DI void phase_ret_prompt(const Params& p, char* lds) {
    constexpr int STP = 264;
    bf16_t* ST = (bf16_t*)lds;
    const int tid = threadIdx.x, lane = tid & 63, w = tid >> 6, l15 = lane & 15, q = lane >> 4;
    for (int item = blockIdx.x; item < BATCH * HA * 8; item += gridDim.x) {
        const int es = item & 7, h = (item >> 3) & 3, b = item >> 5;
        const float lg2 = ret_gamma_log2(h), gam = exp2f(lg2), gam127 = exp2f(lg2 * 127.f);
        f32x4 S[2][4];
#pragma unroll
        for (int i = 0; i < 2; ++i)
#pragma unroll
            for (int j = 0; j < 4; ++j) S[i][j] = (f32x4){0.f, 0.f, 0.f, 0.f};
        __syncthreads();
        for (int i = tid; i < 64 * STP / 8; i += 512) ((bf16x8*)ST)[i] = (bf16x8){0, 0, 0, 0, 0, 0, 0, 0};
        __syncthreads();
        const bf16_t* vTb = p.vT + ((size_t)b * NV + h * DV + es * 64) * SEQ;
        const bf16_t* kTb = p.kT + ((size_t)(b * HA + h) * DK) * SEQ;
        for (int c = 0; c < SEQ / CH; ++c) {
            const int t0 = c * CH; const size_t tokbase = (size_t)b * SEQ + t0;
            bf16x8 qf[8];
#pragma unroll
            for (int ks = 0; ks < 8; ++ks) qf[ks] = *(const bf16x8*)(p.qb + (tokbase + 16 * w + l15) * NQ + h * DK + ks * 32 + q * 8);
            f32x4 O[4];
#pragma unroll
            for (int ef = 0; ef < 4; ++ef) O[ef] = (f32x4){0.f, 0.f, 0.f, 0.f};
#pragma unroll
            for (int ks = 0; ks < 8; ++ks)
#pragma unroll
                for (int ef = 0; ef < 4; ++ef) { const bf16x8 a = *(const bf16x8*)(ST + (16 * ef + l15) * STP + ks * 32 + q * 8); O[ef] = MFMA16(a, qf[ks], O[ef]); }
            for (int jt2 = 0; jt2 <= (w >> 1); ++jt2) {
                f32x4 pt0 = (f32x4){0.f, 0.f, 0.f, 0.f}, pt1 = pt0;
#pragma unroll
                for (int ks = 0; ks < 8; ++ks) {
                    const bf16x8 k0 = *(const bf16x8*)(p.kb + (tokbase + 32 * jt2 + l15) * NQ + h * DK + ks * 32 + q * 8);
                    const bf16x8 k1 = *(const bf16x8*)(p.kb + (tokbase + 32 * jt2 + 16 + l15) * NQ + h * DK + ks * 32 + q * 8);
                    pt0 = MFMA16(k0, qf[ks], pt0); pt1 = MFMA16(k1, qf[ks], pt1);
                }
                const int i = 16 * w + l15, j0 = 32 * jt2 + 4 * q;
#pragma unroll
                for (int r = 0; r < 4; ++r) { if (j0 + r > i) pt0[r] = 0.f; if (j0 + 16 + r > i) pt1[r] = 0.f; }
                const bf16x8 pf = pack8(pt0, pt1);
#pragma unroll
                for (int ef = 0; ef < 4; ++ef) {
                    const bf16_t* vp = vTb + (size_t)(16 * ef + l15) * SEQ + t0 + 32 * jt2 + 4 * q;
                    const bf16x8 va = cat4(*(const bf16x4*)vp, *(const bf16x4*)(vp + 16));
                    O[ef] = MFMA16(va, pf, O[ef]);
                }
            }
            {
                float ss = 0.f;
#pragma unroll
                for (int ef = 0; ef < 4; ++ef) { *(bf16x4*)(p.obuf + (tokbase + 16 * w + l15) * NV + h * DV + es * 64 + 16 * ef + 4 * q) = pack4(O[ef]); for (int r = 0; r < 4; ++r) ss += O[ef][r] * O[ef][r]; }
                ss += __shfl_xor(ss, 16); ss += __shfl_xor(ss, 32);
                if (q == 0) p.ssq[(tokbase + 16 * w + l15) * 32 + h * 8 + es] = ss;
            }
#pragma unroll
            for (int i = 0; i < 2; ++i)
#pragma unroll
                for (int j = 0; j < 4; ++j) S[i][j] = S[i][j] * gam;
#pragma unroll
            for (int ks2 = 0; ks2 < 4; ++ks2) {
                bf16x8 ka[2], vb_[4];
#pragma unroll
                for (int i = 0; i < 2; ++i) ka[i] = *(const bf16x8*)(kTb + (size_t)(32 * w + 16 * i + l15) * SEQ + t0 + 32 * ks2 + 8 * q);
#pragma unroll
                for (int j = 0; j < 4; ++j) vb_[j] = *(const bf16x8*)(vTb + (size_t)(16 * j + l15) * SEQ + t0 + 32 * ks2 + 8 * q);
#pragma unroll
                for (int i = 0; i < 2; ++i)
#pragma unroll
                    for (int j = 0; j < 4; ++j) S[i][j] = MFMA16(ka[i], vb_[j], S[i][j]);
            }
#pragma unroll
            for (int i = 0; i < 2; ++i)
#pragma unroll
                for (int j = 0; j < 4; ++j) S[i][j] = S[i][j] * gam127;
            __syncthreads();
#pragma unroll
            for (int i = 0; i < 2; ++i)
#pragma unroll
                for (int j = 0; j < 4; ++j) *(bf16x4*)(ST + (16 * j + l15) * STP + 32 * w + 16 * i + 4 * q) = pack4(S[i][j] * gam);
            __syncthreads();
        }
        float* so = p.ret_prompt + ((size_t)(b * HA + h) * DK) * DV + es * 64;
#pragma unroll
        for (int i = 0; i < 2; ++i)
#pragma unroll
            for (int j = 0; j < 4; ++j)
#pragma unroll
                for (int r = 0; r < 4; ++r) so[(size_t)(32 * w + 16 * i + 4 * q + r) * DV + 16 * j + l15] = S[i][j][r];
    }
}
DI void phase_ret_sample(const Params& p, char* lds) {
    float* Lq = (float*)lds; float* Lk = Lq + 2048; float* LP = Lk + 2048; float* Lo = LP + 64;
    const int tid = threadIdx.x, lane = tid & 63, w = tid >> 6;
    for (int item = blockIdx.x; item < DB * HA; item += gridDim.x) {
        const int b = item >> 2, h = item & 3; const size_t tok0 = (size_t)TP + b * DS;
        const float lg2 = ret_gamma_log2(h), gam = exp2f(lg2), g7 = exp2f(lg2 * 7.f), g8 = exp2f(lg2 * 8.f);
        __syncthreads();
        for (int i = tid; i < 2048; i += 512) { const int t = i >> 8, d = i & 255; Lq[i] = bf2f(p.qb[(tok0 + t) * NQ + h * DK + d]); Lk[i] = bf2f(p.kb[(tok0 + t) * NQ + h * DK + d]); }
        __syncthreads();
        if (tid < 64) { const int i = tid >> 3, j = tid & 7; float s = 0.f; if (j <= i) for (int d = 0; d < DK; ++d) s += Lq[i * 256 + d] * Lk[j * 256 + d]; LP[tid] = s; }
        const int dq = tid >> 7, e0 = (tid & 127) * 4;
        f32x4 vv[8], oacc[8];
#pragma unroll
        for (int j = 0; j < 8; ++j) { const bf16x4 t = *(const bf16x4*)(p.vb + (tok0 + j) * NV + h * DV + e0); for (int e = 0; e < 4; ++e) vv[j][e] = bf2f((bf16_t)t[e]); oacc[j] = (f32x4){0.f, 0.f, 0.f, 0.f}; }
        const float* S0 = p.state_ret + ((size_t)(b * HA + h) * DK) * DV; float* S1 = p.ret_sample + ((size_t)(b * HA + h) * DK) * DV;
        for (int dd = 0; dd < 64; ++dd) {
            const int d = dq + 4 * dd;
            const f32x4 s = *(const f32x4*)(S0 + (size_t)d * DV + e0);
            f32x4 upd = (f32x4){0.f, 0.f, 0.f, 0.f};
#pragma unroll
            for (int j = 0; j < 8; ++j) { upd += vv[j] * Lk[j * 256 + d]; oacc[j] += s * Lq[j * 256 + d]; }
            *(f32x4*)(S1 + (size_t)d * DV + e0) = s * g8 + upd * g7;
        }
#pragma unroll
        for (int i = 0; i < 8; ++i) *(f32x4*)(Lo + (dq * 8 + i) * 512 + e0) = oacc[i];
        __syncthreads();
        {
            const int i = w, e8 = lane * 8; float o[8]; float ss = 0.f;
#pragma unroll
            for (int e = 0; e < 8; ++e) o[e] = gam * (Lo[(0 * 8 + i) * 512 + e8 + e] + Lo[(1 * 8 + i) * 512 + e8 + e] + Lo[(2 * 8 + i) * 512 + e8 + e] + Lo[(3 * 8 + i) * 512 + e8 + e]);
            for (int j = 0; j <= i; ++j) { const float pj = LP[i * 8 + j]; const bf16x8 t = *(const bf16x8*)(p.vb + (tok0 + j) * NV + h * DV + e8); for (int e = 0; e < 8; ++e) o[e] += pj * bf2f((bf16_t)t[e]); }
            f32x4 a, c; for (int e = 0; e < 4; ++e) { a[e] = o[e]; c[e] = o[4 + e]; ss += o[e] * o[e] + o[4 + e] * o[4 + e]; }
            *(bf16x8*)(p.obuf + (tok0 + i) * NV + h * DV + e8) = pack8(a, c);
            ss = wave_sum(ss);
            if (lane < 8) p.ssq[(tok0 + i) * 32 + h * 8 + lane] = lane == 0 ? ss : 0.f;
        }
    }
}
DI void phase_ret_act(const Params& p) {
    const int gtid = blockIdx.x * 512 + threadIdx.x, gn = gridDim.x * 512;
    for (int idx = gtid; idx < TT * (NV / 8); idx += gn) {
        const int tok = idx / (NV / 8), c8 = (idx % (NV / 8)) * 8, h = c8 / DV;
        const float* sp = p.ssq + (size_t)tok * 32 + h * 8; float s = 0.f; for (int k = 0; k < 8; ++k) s += sp[k];
        const float rstd = 1.0f / sqrtf(s * (1.0f / DV) + 1e-6f);
        const bf16x8 o = *(const bf16x8*)(p.obuf + (size_t)tok * NV + c8), g = *(const bf16x8*)(p.sgb + (size_t)tok * NV + c8);
        f32x4 a, c; for (int e = 0; e < 4; ++e) { a[e] = bf2f((bf16_t)o[e]) * rstd * bf2f((bf16_t)g[e]); c[e] = bf2f((bf16_t)o[4 + e]) * rstd * bf2f((bf16_t)g[4 + e]); }
        *(bf16x8*)(p.actr + (size_t)tok * NV + c8) = pack8(a, c);
    }
}
DI void phase_conv_act(const Params& p, int l) {
    const int gtid = blockIdx.x * 512 + threadIdx.x, gn = gridDim.x * 512;
    const float* cw = p.conv_w + (size_t)l * 3 * F2; const float* cb = p.conv_b + (size_t)l * F2;
    for (int idx = gtid; idx < TT * (DFF / 8); idx += gn) {
        const int tok = idx / (DFF / 8), c = (idx % (DFF / 8)) * 8;
        const int t = tok < TP ? tok % SEQ : (tok - TP) % DS;
        const float* hist = tok < TP ? nullptr : p.state_conv + ((size_t)l * DB + (tok - TP) / DS) * 2 * F2;
        float za[8], zg[8];
#pragma unroll
        for (int half = 0; half < 2; ++half) {
            const int col = half * DFF + c; float* z = half ? zg : za;
            const bf16x8 u2 = *(const bf16x8*)(p.u + (size_t)tok * F2 + col);
            float x0[8], x1[8];
            if (t >= 1) { const bf16x8 v = *(const bf16x8*)(p.u + (size_t)(tok - 1) * F2 + col); for (int e = 0; e < 8; ++e) x1[e] = bf2f((bf16_t)v[e]); }
            else { for (int e = 0; e < 8; ++e) x1[e] = hist ? hist[F2 + col + e] : 0.f; }
            if (t >= 2) { const bf16x8 v = *(const bf16x8*)(p.u + (size_t)(tok - 2) * F2 + col); for (int e = 0; e < 8; ++e) x0[e] = bf2f((bf16_t)v[e]); }
            else { for (int e = 0; e < 8; ++e) x0[e] = hist ? hist[(size_t)t * F2 + col + e] : 0.f; }
            for (int e = 0; e < 8; ++e) z[e] = cb[col + e] + cw[col + e] * x0[e] + cw[F2 + col + e] * x1[e] + cw[2 * F2 + col + e] * bf2f((bf16_t)u2[e]);
        }
        f32x4 a, b2; for (int e = 0; e < 4; ++e) { a[e] = siluf(zg[e]) * za[e]; b2[e] = siluf(zg[4 + e]) * za[4 + e]; }
        *(bf16x8*)(p.actf + (size_t)tok * DFF + c) = pack8(a, b2);
    }
}

constexpr float NEG = -1.0e30f;
constexpr int ANH = 1;
template <int MODE>
DI void attn_kblock(const Params& p, int b, int g, int jblk, int t, int lane, const bf16x8 (&qf)[ANH][2], const float (&slope)[ANH], unsigned selmask,
                    float (&m)[ANH], float (&l)[ANH], f32x4 (&O)[ANH][4]) {
    const int l15 = lane & 15, q = lane >> 4;
    bf16x8 kf[4][2];
    const bf16_t* kb_ = p.kvb + ((size_t)b * SEQ + 64 * jblk) * NKV + (MODE == 0 ? 512 : 1024) + g * 64;
#pragma unroll
    for (int kt = 0; kt < 4; ++kt)
#pragma unroll
        for (int ks = 0; ks < 2; ++ks) kf[kt][ks] = *(const bf16x8*)(kb_ + (unsigned)((16 * kt + l15) * NKV + ks * 32 + q * 8));
    const bf16_t* vTb = (MODE == 0 ? p.vTs : p.vTw) + ((size_t)b * 256 + g * 64) * SEQ + 64 * jblk;
    const unsigned voff = (unsigned)(l15 * SEQ + 4 * q);
    const bool tok_ok = MODE == 0 ? (((selmask >> jblk) & 1u) != 0u) : true;
#pragma unroll
    for (int hh = 0; hh < ANH; ++hh) {
        f32x4 sT[4];
#pragma unroll
        for (int kt = 0; kt < 4; ++kt) { f32x4 acc = (f32x4){0.f, 0.f, 0.f, 0.f}; acc = MFMA16(kf[kt][0], qf[hh][0], acc); acc = MFMA16(kf[kt][1], qf[hh][1], acc); sT[kt] = acc; }
        float mx = NEG;
#pragma unroll
        for (int kt = 0; kt < 4; ++kt)
#pragma unroll
            for (int r = 0; r < 4; ++r) {
                const int dist = t - (64 * jblk + 16 * kt + 4 * q + r);
                const bool valid = tok_ok && dist >= 0 && (MODE == 0 || dist <= WINDOW);
                const float sv = valid ? sT[kt][r] - slope[hh] * (float)dist : NEG;
                sT[kt][r] = sv; mx = fmaxf(mx, sv);
            }
        mx = fmaxf(mx, __shfl_xor(mx, 16)); mx = fmaxf(mx, __shfl_xor(mx, 32));
        const float mnew = fmaxf(m[hh], mx);
        const float alpha = __expf(m[hh] - mnew);
        float psum = 0.f;
#pragma unroll
        for (int kt = 0; kt < 4; ++kt)
#pragma unroll
            for (int r = 0; r < 4; ++r) { const float pe = sT[kt][r] > 0.5f * NEG ? __expf(sT[kt][r] - mnew) : 0.f; sT[kt][r] = pe; psum += pe; }
        l[hh] = l[hh] * alpha + psum; m[hh] = mnew;
#pragma unroll
        for (int df = 0; df < 4; ++df) O[hh][df] = O[hh][df] * alpha;
#pragma unroll
        for (int ks2 = 0; ks2 < 2; ++ks2) {
            const bf16x8 pf = pack8(sT[2 * ks2], sT[2 * ks2 + 1]);
#pragma unroll
            for (int df = 0; df < 4; ++df) { const bf16_t* vp = vTb + (voff + (unsigned)(16 * df * SEQ + 32 * ks2)); O[hh][df] = MFMA16(cat4(*(const bf16x4*)vp, *(const bf16x4*)(vp + 16)), pf, O[hh][df]); }
        }
    }
}
DI f32x4 cmp_tile(const Params& p, int b, int g, int kt, int t, int lane, bf16x8 q0, bf16x8 q1, float slope_h) {
    const int l15 = lane & 15, q = lane >> 4;
    const bf16_t* kp = p.kc + (unsigned)(((b * NCBS + 16 * kt + l15) * 4 + g) * 64 + q * 8);
    f32x4 acc = (f32x4){0.f, 0.f, 0.f, 0.f};
    acc = MFMA16(*(const bf16x8*)kp, q0, acc); acc = MFMA16(*(const bf16x8*)(kp + 32), q1, acc);
#pragma unroll
    for (int r = 0; r < 4; ++r) { const int n = 16 * kt + 4 * q + r, cend = 16 * n + 31; acc[r] = (n < NCB_P && cend <= t) ? acc[r] - slope_h * (float)(t - cend) : NEG; }
    return acc;
}
DI void phase_attn_prompt(const Params& p, char* lds) {
    const int tid = threadIdx.x, lane0 = tid & 63, w = UNIFORM(tid >> 6);
    float* pkey = (float*)lds + (size_t)w * (16 * 128 + 16 * 32);
    float* impL = pkey + 16 * 128;
    constexpr int NTT = SEQ / 16, NITEMS = BATCH * GB * NTT;
    for (int item = blockIdx.x * 8 + w; item < NITEMS; item += gridDim.x * 8) {
        int lane = lane0; OPAQUE(lane);
        const int l15 = lane & 15, q = lane >> 4;
        const int tt = NTT - 1 - (item % NTT), g = (item / NTT) % GB, b = item / (NTT * GB);
        const int t0 = 16 * tt, t = t0 + l15; const unsigned tok = (unsigned)(b * SEQ + t);
        const float* gt = p.gates + (tok * 48u + (unsigned)(g * 12));
        int ncv = (t0 + 15 >= 31) ? (t0 + 15 - 31) / 16 + 1 : 0; ncv = ncv < NCB_P ? ncv : NCB_P;
        const int nkt = (ncv + 15) >> 4;
        float mC[4], ilC[4];
#pragma unroll
        for (int kt = 0; kt < 8; ++kt) *(f32x4*)(pkey + l15 * 128 + 16 * kt + 4 * q) = (f32x4){0.f, 0.f, 0.f, 0.f};
#pragma unroll
        for (int hh = 0; hh < 4; ++hh) {
            const float slope_h = exp2f(-0.5f * (float)(g * 4 + hh + 1));
            const bf16x8 q0 = *(const bf16x8*)(p.qb + (tok * 1024u + (unsigned)((g * 4 + hh) * 64 + q * 8))), q1 = *(const bf16x8*)(p.qb + (tok * 1024u + (unsigned)((g * 4 + hh) * 64 + 32 + q * 8)));
            float mx = NEG, sm = 0.f;
#pragma unroll 1
            for (int kt = 0; kt < nkt; ++kt) {
                const f32x4 sv = cmp_tile(p, b, g, kt, t, lane, q0, q1, slope_h);
                const float tm = fmaxf(fmaxf(sv[0], sv[1]), fmaxf(sv[2], sv[3])), mn = fmaxf(mx, tm);
                float e = 0.f;
#pragma unroll
                for (int r = 0; r < 4; ++r) e += sv[r] > 0.5f * NEG ? __expf(sv[r] - mn) : 0.f;
                sm = sm * __expf(mx - mn) + e; mx = mn;
            }
            float ma = fmaxf(mx, __shfl_xor(mx, 16)); ma = fmaxf(ma, __shfl_xor(ma, 32));
            sm *= __expf(mx - ma); sm += __shfl_xor(sm, 16); sm += __shfl_xor(sm, 32);
            mC[hh] = ma; ilC[hh] = 1.0f / fmaxf(sm, 1e-30f);
#pragma unroll 1
            for (int kt = 0; kt < nkt; ++kt) {
                const f32x4 sv = cmp_tile(p, b, g, kt, t, lane, q0, q1, slope_h);
                f32x4 pv;
#pragma unroll
                for (int r = 0; r < 4; ++r) pv[r] = sv[r] > 0.5f * NEG ? __expf(sv[r] - ma) * ilC[hh] : 0.f;
                float* pk = pkey + l15 * 128 + 16 * kt + 4 * q;
                *(f32x4*)pk = *(const f32x4*)pk + pv;
            }
        }
        WAVE_SYNC();
        const int cur = t >> 6;
        float sc8[8];
#pragma unroll
        for (int f = 0; f < 8; ++f) {
            const int j = 4 * f + q; float imp = 0.f;
#pragma unroll
            for (int dn = -1; dn <= 3; ++dn) { const int n = 4 * j + dn; if (n >= 0 && n < 128) imp += pkey[l15 * 128 + n]; }
            const bool forced = (j == 0) || (j == cur) || (j == cur - 1);
            sc8[f] = j <= cur ? imp + (forced ? 1.0e4f : 0.f) : NEG;
            impL[l15 * 32 + j] = sc8[f];
        }
        WAVE_SYNC();
        unsigned selmask = 0u;
#pragma unroll
        for (int f = 0; f < 8; ++f) {
            const int j = 4 * f + q; const float sv = sc8[f]; int rank = 0;
            for (int jj = 0; jj < 32; ++jj) { const float sj = impL[l15 * 32 + jj]; rank += (sj > sv || (sj == sv && jj < j)) ? 1 : 0; }
            if (j <= cur && rank < NSEL) selmask |= 1u << j;
        }
        selmask |= __shfl_xor(selmask, 16); selmask |= __shfl_xor(selmask, 32);
        WAVE_SYNC();
#pragma unroll 1
        for (int hp = 0; hp < 4 / ANH; ++hp) {
            bf16x8 qf[ANH][2]; float slope[ANH]; f32x4 outv[ANH][4];
#pragma unroll
            for (int hh = 0; hh < ANH; ++hh) { const int head = g * 4 + hp * ANH + hh; slope[hh] = exp2f(-0.5f * (float)(head + 1)); for (int ks = 0; ks < 2; ++ks) qf[hh][ks] = *(const bf16x8*)(p.qb + (tok * 1024u + (unsigned)(head * 64 + ks * 32 + q * 8))); }
#pragma unroll
            for (int hh = 0; hh < ANH; ++hh) {
                const int h4 = hp * ANH + hh; const float ma = h4 == 0 ? mC[0] : h4 == 1 ? mC[1] : h4 == 2 ? mC[2] : mC[3], il = h4 == 0 ? ilC[0] : h4 == 1 ? ilC[1] : h4 == 2 ? ilC[2] : ilC[3];
                f32x4 Oc[4];
#pragma unroll
                for (int df = 0; df < 4; ++df) Oc[df] = (f32x4){0.f, 0.f, 0.f, 0.f};
#pragma unroll 1
                for (int k2 = 0; 2 * k2 < nkt; ++k2) {
                    f32x4 s0 = cmp_tile(p, b, g, 2 * k2, t, lane, qf[hh][0], qf[hh][1], slope[hh]), s1 = cmp_tile(p, b, g, 2 * k2 + 1, t, lane, qf[hh][0], qf[hh][1], slope[hh]);
#pragma unroll
                    for (int r = 0; r < 4; ++r) { s0[r] = s0[r] > 0.5f * NEG ? __expf(s0[r] - ma) * il : 0.f; s1[r] = s1[r] > 0.5f * NEG ? __expf(s1[r] - ma) * il : 0.f; }
                    const bf16x8 pf = pack8(s0, s1);
#pragma unroll
                    for (int df = 0; df < 4; ++df) { const bf16_t* vp = p.vcT + (unsigned)(((b * 4 + g) * 64 + 16 * df + l15) * NCBS + 32 * k2 + 4 * q); Oc[df] = MFMA16(cat4(*(const bf16x4*)vp, *(const bf16x4*)(vp + 16)), pf, Oc[df]); }
                }
                const float gate = gt[(hp * ANH + hh) * 3];
#pragma unroll
                for (int df = 0; df < 4; ++df) outv[hh][df] = Oc[df] * gate;
            }
            float m[ANH], l[ANH]; f32x4 O[ANH][4];
#pragma unroll 1
            for (int br = 0; br < 2; ++br) {
#pragma unroll
                for (int hh = 0; hh < ANH; ++hh) { m[hh] = NEG; l[hh] = 0.f; for (int df = 0; df < 4; ++df) O[hh][df] = (f32x4){0.f, 0.f, 0.f, 0.f}; }
                const int jhi = (t0 + 15) >> 6;
                if (br == 0) {
#pragma unroll 1
                    for (int jb = 0; jb <= jhi; ++jb) { if (__ballot((selmask >> jb) & 1u) == 0ull) continue; attn_kblock<0>(p, b, g, jb, t, lane, qf, slope, selmask, m, l, O); }
                } else { const int jlo = (t0 - WINDOW) > 0 ? (t0 - WINDOW) >> 6 : 0;
#pragma unroll 1
                    for (int jb = jlo; jb <= jhi; ++jb) attn_kblock<1>(p, b, g, jb, t, lane, qf, slope, selmask, m, l, O);
                }
#pragma unroll
                for (int hh = 0; hh < ANH; ++hh) {
                    float lt = l[hh]; lt += __shfl_xor(lt, 16); lt += __shfl_xor(lt, 32);
                    const float sc = gt[(hp * ANH + hh) * 3 + 1 + br] / fmaxf(lt, 1e-30f);
#pragma unroll
                    for (int df = 0; df < 4; ++df) outv[hh][df] += O[hh][df] * sc;
                }
            }
#pragma unroll
            for (int hh = 0; hh < ANH; ++hh)
#pragma unroll
                for (int df = 0; df < 4; ++df) *(bf16x4*)(p.ao + (tok * 1024u + (unsigned)((g * 4 + hp * ANH + hh) * 64 + 16 * df + 4 * q))) = pack4(outv[hh][df]);
        }
    }
}

template <int MODE>
DI void attn_sample_unit(const Params& p, int b, int g, int blk, int lane, const bf16x8 (&qf)[2][2], const float (&slope)[2], const unsigned long long* Lsel, bf16_t* Lvt,
                         float (&m)[2], float (&l)[2], f32x4 (&O)[2][4]) {
    const int l15 = lane & 15, q = lane >> 4;
    auto rowptr = [&](int kk, bool isv) -> const float* {
        if (MODE == 0) { const int pos = 64 * blk + kk;
            if (pos < PAST) return p.cache_kv + ((size_t)p.page_table[b * NPAGES + (pos >> 7)] * PAGE + (pos & 127)) * 1024 + (isv ? 768 : 512) + g * 64;
            if (pos < PAST + DS) return p.kv_sample + ((size_t)(b * DS + pos - PAST)) * 1024 + (isv ? 768 : 512) + g * 64;
            return nullptr; }
        const int idx = 64 * blk + kk;
        if (idx < WBUF) return p.state_win + ((size_t)b * WBUF + idx) * 512 + (isv ? 256 : 0) + g * 64;
        if (idx < WBUF + DS) return p.win_sample + ((size_t)b * WINS + WINS - DS + idx - WBUF) * 512 + (isv ? 256 : 0) + g * 64;
        return nullptr; };
    bf16x8 kf[4][2];
#pragma unroll
    for (int kt = 0; kt < 4; ++kt) { const float* rp = rowptr(16 * kt + l15, false);
#pragma unroll
        for (int ks = 0; ks < 2; ++ks) kf[kt][ks] = rp ? pack8(*(const f32x4*)(rp + ks * 32 + q * 8), *(const f32x4*)(rp + ks * 32 + q * 8 + 4)) : (bf16x8){0, 0, 0, 0, 0, 0, 0, 0}; }
    WAVE_SYNC();
#pragma unroll
    for (int it = 0; it < 16; ++it) { const int kk = it * 4 + q; const float* rp = rowptr(kk, true); const f32x4 v = rp ? *(const f32x4*)(rp + l15 * 4) : (f32x4){0.f, 0.f, 0.f, 0.f};
        for (int e = 0; e < 4; ++e) Lvt[(l15 * 4 + e) * 72 + kk] = f2bf(v[e]); }
    WAVE_SYNC();
    const int i = l15 & 7, tpos = PAST + i;
    const bool tok_ok = MODE == 0 ? (((Lsel[i] >> blk) & 1ull) != 0ull) : true;
    const int kbase = MODE == 0 ? 64 * blk : PAST - WBUF + 64 * blk;
#pragma unroll
    for (int rf = 0; rf < 2; ++rf) {
        f32x4 sT[4];
#pragma unroll
        for (int kt = 0; kt < 4; ++kt) { f32x4 acc = (f32x4){0.f, 0.f, 0.f, 0.f}; acc = MFMA16(kf[kt][0], qf[rf][0], acc); acc = MFMA16(kf[kt][1], qf[rf][1], acc); sT[kt] = acc; }
        float mx = NEG;
#pragma unroll
        for (int kt = 0; kt < 4; ++kt)
#pragma unroll
            for (int r = 0; r < 4; ++r) {
                const int kk = 16 * kt + 4 * q + r, dist = tpos - (kbase + kk);
                const bool valid = tok_ok && dist >= 0 && (MODE == 0 || (dist <= WINDOW && 64 * blk + kk < WBUF + DS));
                const float sv = valid ? sT[kt][r] - slope[rf] * (float)dist : NEG; sT[kt][r] = sv; mx = fmaxf(mx, sv);
            }
        mx = fmaxf(mx, __shfl_xor(mx, 16)); mx = fmaxf(mx, __shfl_xor(mx, 32));
        const float mnew = fmaxf(m[rf], mx), alpha = __expf(m[rf] - mnew);
        float psum = 0.f;
#pragma unroll
        for (int kt = 0; kt < 4; ++kt)
#pragma unroll
            for (int r = 0; r < 4; ++r) { const float pe = sT[kt][r] > 0.5f * NEG ? __expf(sT[kt][r] - mnew) : 0.f; sT[kt][r] = pe; psum += pe; }
        l[rf] = l[rf] * alpha + psum; m[rf] = mnew;
#pragma unroll
        for (int df = 0; df < 4; ++df) O[rf][df] = O[rf][df] * alpha;
#pragma unroll
        for (int ks2 = 0; ks2 < 2; ++ks2) { const bf16x8 pf = pack8(sT[2 * ks2], sT[2 * ks2 + 1]);
#pragma unroll
            for (int df = 0; df < 4; ++df) { const bf16_t* vp = Lvt + (16 * df + l15) * 72 + 32 * ks2 + 4 * q; O[rf][df] = MFMA16(cat4(*(const bf16x4*)vp, *(const bf16x4*)(vp + 16)), pf, O[rf][df]); } }
    }
}
DI void phase_attn_sample(const Params& p, char* lds) {
    const int tid = threadIdx.x, lane = tid & 63, w = tid >> 6, l15 = lane & 15, q = lane >> 4;
    float* Lsc = (float*)lds;
    float* Lpt = Lsc + 32 * 128;
    float* Lscore = Lpt + 8 * 128;
    unsigned long long* Lsel = (unsigned long long*)(Lscore + 8 * 64);
    float* Locmp = (float*)(Lsel + 16);
    bf16_t* Lvt_all = (bf16_t*)(Locmp + 32 * 64);
    float* Lcomb = (float*)Lvt_all;
    constexpr int NWB = (WBUF + DS + 63) / 64;
    for (int item = blockIdx.x; item < DB * GB; item += gridDim.x) {
        const int b = item >> 2, g = item & 3, bb = BATCH + b;
        __syncthreads();
        bf16x8 qf[2][2]; float slope[2];
#pragma unroll
        for (int rf = 0; rf < 2; ++rf) { const int head = 2 * rf + (l15 >> 3), i = l15 & 7; slope[rf] = exp2f(-0.5f * (float)(g * 4 + head + 1));
            for (int ks = 0; ks < 2; ++ks) qf[rf][ks] = *(const bf16x8*)(p.qb + ((size_t)TP + b * DS + i) * 1024 + (g * 4 + head) * 64 + ks * 32 + q * 8); }
        {
            const bf16_t* kp = p.kc + ((size_t)(bb * NCBS + 16 * w + l15) * 4 + g) * 64 + q * 8;
            const bf16x8 k0 = *(const bf16x8*)kp, k1 = *(const bf16x8*)(kp + 32);
#pragma unroll
            for (int rf = 0; rf < 2; ++rf) {
                f32x4 acc = (f32x4){0.f, 0.f, 0.f, 0.f}; acc = MFMA16(k0, qf[rf][0], acc); acc = MFMA16(k1, qf[rf][1], acc);
                const int R = rf * 16 + l15, tpos = PAST + (l15 & 7);
                for (int r = 0; r < 4; ++r) { const int n = 16 * w + 4 * q + r, cend = 16 * n + 31; Lsc[R * 128 + n] = (n < NCB_S && cend <= tpos) ? acc[r] - slope[rf] * (float)(tpos - cend) : NEG; }
            }
        }
        __syncthreads();
        {
            const int i = w, tpos = PAST + i, cur = tpos >> 6; float pt0 = 0.f, pt1 = 0.f;
            for (int hh = 0; hh < 4; ++hh) {
                const int R = hh * 8 + i; const float s0 = Lsc[R * 128 + lane], s1 = Lsc[R * 128 + 64 + lane];
                const float mx = wave_max(fmaxf(s0, s1));
                const float e0 = s0 > 0.5f * NEG ? __expf(s0 - mx) : 0.f, e1 = s1 > 0.5f * NEG ? __expf(s1 - mx) : 0.f;
                const float inv = 1.0f / fmaxf(wave_sum(e0 + e1), 1e-30f);
                Lsc[R * 128 + lane] = e0 * inv; Lsc[R * 128 + 64 + lane] = e1 * inv; pt0 += e0 * inv; pt1 += e1 * inv;
            }
            Lpt[i * 128 + lane] = pt0; Lpt[i * 128 + 64 + lane] = pt1;
            WAVE_SYNC();
            const int j = lane; float sv = NEG;
            if (j < NSELB_S && j <= cur) { float imp = 0.f; for (int n = 4 * j - 1; n <= 4 * j + 3; ++n) if (n >= 0 && n < NCB_S) imp += Lpt[i * 128 + n];
                const bool forced = (j == 0) || (j == cur) || (j == cur - 1); sv = imp + (forced ? 1.0e4f : 0.f); }
            Lscore[i * 64 + j] = sv;
            WAVE_SYNC();
            int rank = 0; for (int jj = 0; jj < NSELB_S; ++jj) { const float sj = Lscore[i * 64 + jj]; rank += (sj > sv || (sj == sv && jj < j)) ? 1 : 0; }
            const unsigned long long mask = __ballot(j < NSELB_S && j <= cur && rank < NSEL);
            if (lane == 0) Lsel[i] = mask;
        }
        __syncthreads();
        {
            const int df = w >> 1, rf = w & 1, R = rf * 16 + l15; f32x4 acc = (f32x4){0.f, 0.f, 0.f, 0.f};
#pragma unroll
            for (int ks = 0; ks < 4; ++ks) {
                const bf16x8 va = *(const bf16x8*)(p.vcT + ((size_t)(bb * 4 + g) * 64 + 16 * df + l15) * NCBS + 32 * ks + 8 * q);
                const float* pp = Lsc + R * 128 + 32 * ks + 8 * q;
                acc = MFMA16(va, pack8(*(const f32x4*)pp, *(const f32x4*)(pp + 4)), acc);
            }
            for (int r = 0; r < 4; ++r) Locmp[R * 64 + 16 * df + 4 * q + r] = acc[r];
        }
        unsigned long long U = 0ull;
        for (int i = 0; i < 8; ++i) U |= Lsel[i];
        const int nslc = __builtin_popcountll(U);
        bf16_t* Lvt = Lvt_all + w * (64 * 72);
        f32x4 outv = (f32x4){0.f, 0.f, 0.f, 0.f};
        const int cR = tid >> 4, cd = (tid & 15) * 4, chead = cR >> 3, ci = cR & 7;
        const float* gt = p.gates + ((size_t)TP + b * DS + ci) * 48 + (g * 4 + chead) * 3;
#pragma unroll 1
        for (int br = 0; br < 2; ++br) {
            float m[2], l[2]; f32x4 O[2][4];
#pragma unroll
            for (int rf = 0; rf < 2; ++rf) { m[rf] = NEG; l[rf] = 0.f; for (int df = 0; df < 4; ++df) O[rf][df] = (f32x4){0.f, 0.f, 0.f, 0.f}; }
            if (br == 0) {
#pragma unroll 1
                for (int u = w; u < nslc; u += 8) { unsigned long long rem = U; for (int k = 0; k < u; ++k) rem &= rem - 1ull; const int jb = __builtin_ctzll(rem); attn_sample_unit<0>(p, b, g, jb, lane, qf, slope, Lsel, Lvt, m, l, O); }
            } else {
#pragma unroll 1
                for (int u = (w + 8 - (nslc & 7)) & 7; u < NWB; u += 8) attn_sample_unit<1>(p, b, g, u, lane, qf, slope, Lsel, Lvt, m, l, O);
            }
            __syncthreads();
#pragma unroll
            for (int rf = 0; rf < 2; ++rf) {
                float lt = l[rf]; lt += __shfl_xor(lt, 16); lt += __shfl_xor(lt, 32);
                const int R = rf * 16 + l15;
                if (q == 0) { Lcomb[w * 2112 + 2048 + R] = m[rf]; Lcomb[w * 2112 + 2080 + R] = lt; }
#pragma unroll
                for (int df = 0; df < 4; ++df) { for (int r = 0; r < 4; ++r) Lcomb[w * 2112 + R * 64 + 16 * df + 4 * q + r] = O[rf][df][r]; }
            }
            __syncthreads();
            float M = NEG; for (int ww = 0; ww < 8; ++ww) M = fmaxf(M, Lcomb[ww * 2112 + 2048 + cR]);
            float L = 0.f; f32x4 o = (f32x4){0.f, 0.f, 0.f, 0.f};
            for (int ww = 0; ww < 8; ++ww) { const float sc = __expf(Lcomb[ww * 2112 + 2048 + cR] - M); L += Lcomb[ww * 2112 + 2080 + cR] * sc; o += *(const f32x4*)(Lcomb + ww * 2112 + cR * 64 + cd) * sc; }
            outv += o * (gt[1 + br] / fmaxf(L, 1e-30f));
            __syncthreads();
        }
        outv += *(const f32x4*)(Locmp + cR * 64 + cd) * gt[0];
        *(bf16x4*)(p.ao + ((size_t)TP + b * DS + ci) * 1024 + (g * 4 + chead) * 64 + cd) = pack4(outv);
    }
}

constexpr int LDS_BYTES = 147456;
constexpr int NPHASE = 22;
#define PHASE(k) if (p.ph_lo <= (k) && (k) < p.ph_hi)
#define SEAM(k) if (p.ph_lo <= (k) && (k) + 1 < p.ph_hi) grid_barrier(bar)
__global__ void __launch_bounds__(512, 2) mega(Params p) {
    char* lds = lds_base();
#ifdef EMU
    XcdBarrier bar{0};
#else
    if (threadIdx.x == 0) *(uint4*)(lds + LDS_BYTES - 16) = make_uint4(0u, 0u, 0u, 0u);
    __syncthreads();
    XcdBarrier bar = xcd_barrier_post(p.bar, (volatile LAS unsigned*)(lds + LDS_BYTES - 16));
#endif
    PHASE(0) phase_prologue(p, lds);
    SEAM(0);
    PHASE(1) { EpiAda e{p.mod, p.b_ada, p.b_ada_kv}; gemm_phase<true>(256, MODN, D, p.Wada, LoadRowMajor{p.scb, D}, e, lds); }
    SEAM(1);
    PHASE(2) phase_normmod<false>(p, true, p.g_mix, 0, D, p.hbuf, nullptr, 0, 0, nullptr);
    SEAM(2);
    PHASE(3) { EpiRetIn e{p.qb, p.kb, p.vb, p.sgb, p.kT, p.vT}; gemm_phase<true>(TT, RETP, D, p.Wret_in, LoadRowMajor{p.hbuf, D}, e, lds); }
    SEAM(3);
    PHASE(4) { phase_ret_prompt(p, lds); phase_ret_sample(p, lds); }
    SEAM(4);
    PHASE(5) phase_ret_act(p);
    SEAM(5);
    PHASE(6) { EpiResid e{&p, true, 2 * D}; gemm_phase<true>(TT, D, NV, p.Wret_out, LoadRowMajor{p.actr, NV}, e, lds); }
    SEAM(6);
    PHASE(7) phase_normmod<false>(p, false, p.g_ffn, 3 * D, 4 * D, p.hbuf, nullptr, 0, 0, nullptr);
    SEAM(7);
    PHASE(8) { EpiFfnIn e{p.u, p.conv_prompt, p.conv_sample}; gemm_phase<true>(TT, F2, D, p.Wffn_in, LoadRowMajor{p.hbuf, D}, e, lds); }
    SEAM(8);
    PHASE(9) phase_conv_act(p, 0);
    SEAM(9);
    PHASE(10) { EpiResid e{&p, false, 5 * D}; gemm_phase<true>(TT, D, DFF, p.Wffn_out, LoadRowMajor{p.actf, DFF}, e, lds); }
    SEAM(10);
    PHASE(11) phase_normmod<true>(p, false, p.g_mix + D, 6 * D, 7 * D, p.hbuf, p.g_kv, 12 * D, 13 * D, p.hkv);
    SEAM(11);
    PHASE(12) {
        { EpiKv e{&p}; gemm_phase<true>(TT, NKV, D, p.Wkv, LoadRowMajor{p.hkv, D}, e, lds); }
        { EpiNsaIn e{p.qb, p.gates}; gemm_phase<true>(TT, NNSA_PAD, D, p.Wnsa_in, LoadRowMajor{p.hbuf, D}, e, lds); }
    }
    SEAM(12);
    PHASE(13) {
        { EpiZ1 e{p.Z1}; gemm_phase<true>(CROWS, 256, 1024, p.Wc1, LoadCmp{&p, 0}, e, lds); }
        { EpiZ1 e{p.Z1 + (size_t)CROWS * 256}; gemm_phase<true>(CROWS, 256, 1024, p.Wc1 + 256 * 1024, LoadCmp{&p, 1}, e, lds); }
    }
    SEAM(13);
    PHASE(14) {
        { EpiCmp2 e{p.kc, p.vcT, 0}; gemm_phase<true>(CROWS, 128, 128, p.Wc2, LoadCmp2{p.Z1, p.cbias}, e, lds); }
        { EpiCmp2 e{p.kc, p.vcT, 1}; gemm_phase<true>(CROWS, 128, 128, p.Wc2 + 128 * 128, LoadCmp2{p.Z1 + (size_t)CROWS * 256, p.cbias + 128}, e, lds); }
    }
    SEAM(14);
    PHASE(15) { phase_attn_sample(p, lds); __syncthreads(); phase_attn_prompt(p, lds); }
    SEAM(15);
    PHASE(16) { EpiResid e{&p, false, 8 * D}; gemm_phase<true>(TT, D, D, p.Wnsa_out, LoadRowMajor{p.ao, D}, e, lds); }
    SEAM(16);
    PHASE(17) phase_normmod<false>(p, false, p.g_ffn + D, 9 * D, 10 * D, p.hbuf, nullptr, 0, 0, nullptr);
    SEAM(17);
    PHASE(18) { EpiFfnIn e{p.u, p.conv_prompt + (size_t)BATCH * 2 * F2, p.conv_sample + (size_t)DB * 2 * F2}; gemm_phase<true>(TT, F2, D, p.Wffn_in + (size_t)F2 * D, LoadRowMajor{p.hbuf, D}, e, lds); }
    SEAM(18);
    PHASE(19) phase_conv_act(p, 1);
    SEAM(19);
    PHASE(20) { EpiResid e{&p, false, 11 * D}; gemm_phase<true>(TT, D, DFF, p.Wffn_out + (size_t)D * DFF, LoadRowMajor{p.actf, DFF}, e, lds); }
    SEAM(20);
    PHASE(21) phase_final_norm(p);
}

extern "C" void kernel_launch(void* const* d_in, const int* in_sizes, int n_in, void* d_out, int out_size, void* d_ws, size_t ws_size, hipStream_t stream) {
    Params p{};
    const float** fin = (const float**)&p.x_prompt;
    p.x_prompt = (const float*)d_in[0]; p.x_sample = (const float*)d_in[1]; p.c_prompt = (const float*)d_in[2]; p.c_sample = (const float*)d_in[3];
    p.state_ret = (const float*)d_in[4]; p.state_conv = (const float*)d_in[5]; p.cache_kv = (const float*)d_in[6]; p.state_win = (const float*)d_in[7];
    p.page_table = (const int*)d_in[8];
    p.w_ada = (const float*)d_in[9]; p.b_ada = (const float*)d_in[10]; p.g_mix = (const float*)d_in[11]; p.g_ffn = (const float*)d_in[12];
    p.w_ffn_in = (const float*)d_in[13]; p.conv_w = (const float*)d_in[14]; p.conv_b = (const float*)d_in[15]; p.w_ffn_out = (const float*)d_in[16];
    p.w_ret_in = (const float*)d_in[17]; p.w_ret_out = (const float*)d_in[18]; p.g_kv = (const float*)d_in[19]; p.w_ada_kv = (const float*)d_in[20];
    p.b_ada_kv = (const float*)d_in[21]; p.w_kv = (const float*)d_in[22]; p.pe_ck = (const float*)d_in[23]; p.pe_cv = (const float*)d_in[24];
    p.w_ck1 = (const float*)d_in[25]; p.w_ck2 = (const float*)d_in[26]; p.w_cv1 = (const float*)d_in[27]; p.w_cv2 = (const float*)d_in[28];
    p.w_nsa_in = (const float*)d_in[29]; p.w_nsa_out = (const float*)d_in[30]; p.g_final = (const float*)d_in[31];
    (void)fin;
    float* o = (float*)d_out;
    p.y_prompt = o; o += (size_t)TP * D; p.y_sample = o; o += (size_t)TS * D;
    p.ret_prompt = o; o += (size_t)BATCH * HA * DK * DV; p.ret_sample = o; o += (size_t)DB * HA * DK * DV;
    p.conv_prompt = o; o += (size_t)2 * BATCH * 2 * F2; p.conv_sample = o; o += (size_t)2 * DB * 2 * F2;
    p.kv_prompt = o; o += (size_t)TP * 1024; p.kv_sample = o; o += (size_t)TS * 1024;
    p.win_prompt = o; o += (size_t)BATCH * WINP * 512; p.win_sample = o; o += (size_t)DB * WINS * 512;
    WsAlloc A;
    p.bar = A.take<unsigned>(d_ws, XCD_BAR_WORDS);
    p.Wada = A.take<bf16_t>(d_ws, (size_t)MODN * D); p.Wret_in = A.take<bf16_t>(d_ws, (size_t)RETP * D); p.Wret_out = A.take<bf16_t>(d_ws, (size_t)D * NV);
    p.Wffn_in = A.take<bf16_t>(d_ws, (size_t)2 * F2 * D); p.Wffn_out = A.take<bf16_t>(d_ws, (size_t)2 * D * DFF); p.Wkv = A.take<bf16_t>(d_ws, (size_t)NKV * D);
    p.Wnsa_in = A.take<bf16_t>(d_ws, (size_t)NNSA_PAD * D); p.Wnsa_out = A.take<bf16_t>(d_ws, (size_t)D * D); p.Wc1 = A.take<bf16_t>(d_ws, (size_t)512 * 1024); p.Wc2 = A.take<bf16_t>(d_ws, 2 * 128 * 128);
    p.cbias = A.take<float>(d_ws, 256); p.mod = A.take<float>(d_ws, (size_t)NBAT * MODN); p.X = A.take<float>(d_ws, (size_t)TT * D);
    p.ssq = A.take<float>(d_ws, (size_t)TT * 32); p.gates = A.take<float>(d_ws, (size_t)TT * 48); p.Z1 = A.take<float>(d_ws, (size_t)2 * CROWS * 256);
    p.scb = A.take<bf16_t>(d_ws, 256 * D); p.hbuf = A.take<bf16_t>(d_ws, (size_t)TT * D); p.hkv = A.take<bf16_t>(d_ws, (size_t)TT * D);
    p.qb = A.take<bf16_t>(d_ws, (size_t)TT * D); p.kb = A.take<bf16_t>(d_ws, (size_t)TT * D); p.vb = A.take<bf16_t>(d_ws, (size_t)TT * NV); p.sgb = A.take<bf16_t>(d_ws, (size_t)TT * NV);
    p.kT = A.take<bf16_t>(d_ws, (size_t)TP * NQ); p.vT = A.take<bf16_t>(d_ws, (size_t)TP * NV); p.obuf = A.take<bf16_t>(d_ws, (size_t)TT * NV); p.actr = A.take<bf16_t>(d_ws, (size_t)TT * NV);
    p.u = A.take<bf16_t>(d_ws, (size_t)TT * F2); p.actf = A.take<bf16_t>(d_ws, (size_t)TT * DFF); p.kvb = A.take<bf16_t>(d_ws, (size_t)TP * NKV);
    p.vTs = A.take<bf16_t>(d_ws, (size_t)TP * 256); p.vTw = A.take<bf16_t>(d_ws, (size_t)TP * 256);
    p.kc = A.take<bf16_t>(d_ws, (size_t)NBAT * NCBS * 256); p.vcT = A.take<bf16_t>(d_ws, (size_t)NBAT * NCBS * 256); p.ao = A.take<bf16_t>(d_ws, (size_t)TT * D);
    if (A.off > ws_size) { fprintf(stderr, "kernel_launch: workspace too small (%zu > %zu)\n", A.off, ws_size); return; }
    hipMemsetAsync(p.bar, 0, XCD_BAR_WORDS * sizeof(unsigned), stream);
#ifdef EMU
    const int grid = 4;
    emu_dbg_register("mod", p.mod, (size_t)NBAT * MODN, 0);
    emu_dbg_register("hbuf", p.hbuf, (size_t)TT * D, 1);
    emu_dbg_register("ao", p.ao, (size_t)TT * D, 1); emu_dbg_register("nq", p.qb, (size_t)TT * D, 1); emu_dbg_register("gates", p.gates, (size_t)TT * 48, 0);
    emu_dbg_register("kc", p.kc, (size_t)NBAT * NCBS * 256, 1); emu_dbg_register("vcT", p.vcT, (size_t)NBAT * NCBS * 256, 1); emu_dbg_register("X1", p.X, (size_t)TT * D, 0);
    emu_dbg_register("obuf", p.obuf, (size_t)TT * NV, 1); emu_dbg_register("actr", p.actr, (size_t)TT * NV, 1);
    emu_dbg_register("u0", p.u, (size_t)TT * F2, 1); emu_dbg_register("actf0", p.actf, (size_t)TT * DFF, 1);
    emu_dbg_register("kb", p.kb, (size_t)TT * D, 1); emu_dbg_register("vb", p.vb, (size_t)TT * NV, 1); emu_dbg_register("sgb", p.sgb, (size_t)TT * NV, 1);
#else
    static int grid = 0;
    if (grid == 0) {
        int dev = 0, cus = 0;
        if (hipGetDevice(&dev) != hipSuccess || hipDeviceGetAttribute(&cus, hipDeviceAttributeMultiprocessorCount, dev) != hipSuccess) { fprintf(stderr, "kernel_launch: device query failed\n"); grid = -1; return; }
        if (hipFuncSetAttribute((const void*)mega, hipFuncAttributeMaxDynamicSharedMemorySize, LDS_BYTES) != hipSuccess) { fprintf(stderr, "kernel_launch: hipFuncSetAttribute failed\n"); grid = -1; return; }
        (void)hipGetLastError();
        grid = cus;
    }
    if (grid < 0) return;
#endif
    p.ph_lo = 0; p.ph_hi = NPHASE;
    LAUNCH(mega, grid, 512, LDS_BYTES, stream, p);
}
```

```cpp
#ifndef EMU
#include <hip/hip_runtime.h>
#include <cstdio>
#include <cstdint>
#endif

#ifndef CFG_BATCH
#define CFG_BATCH 8
#endif
#ifndef CFG_SEQ
#define CFG_SEQ 2048
#endif
#ifndef CFG_DB
#define CFG_DB 128
#endif
#ifndef CFG_PAST
#define CFG_PAST 2048
#endif
#ifndef CFG_NSEL
#define CFG_NSEL 16
#endif
#ifndef CFG_WINDOW
#define CFG_WINDOW 512
#endif
#ifndef CFG_DFF
#define CFG_DFF 2816
#endif
constexpr int BATCH = CFG_BATCH, SEQ = CFG_SEQ, DB = CFG_DB, PAST = CFG_PAST, NSEL = CFG_NSEL, WINDOW = CFG_WINDOW, DFF = CFG_DFF;
constexpr int D = 1024, DS = 8, PAGE = 128, NPAGES = PAST / PAGE;
constexpr int HA = 4, DK = 256, DV = 512, CH = 128, NQ = HA * DK, NV = HA * DV, RETP = 2 * NQ + 2 * NV;
constexpr int HB = 16, DH = 64, GB = 4, HPG = 4, F2 = 2 * DFF;
constexpr int TP = BATCH * SEQ, TS = DB * DS, TT = TP + TS, NBAT = BATCH + DB;
constexpr int NKV = 6 * GB * DH;
constexpr int NNSA = HB * DH + 3 * HB;
constexpr int NNSA_PAD = 1280;
constexpr int NPC_P = SEQ / 16, NPC_S = PAST / 16, NCB_P = NPC_P - 1, NCB_S = NPC_S - 1;
constexpr int NCBS = 128;
constexpr int CROWS_P = BATCH * NPC_P * 4, CROWS_S = DB * NPC_S * 4, CROWS = CROWS_P + CROWS_S, CROWS_PAD = (CROWS + 255) / 256 * 256;
constexpr int WBUF = (WINDOW < PAST ? WINDOW : PAST);
constexpr int WINP = (WINDOW < SEQ ? WINDOW : SEQ);
constexpr int WINS = (WINDOW < WBUF + DS ? WINDOW : WBUF + DS);
constexpr int NSELB_P = SEQ / 64;
constexpr int NSELB_S = (PAST + DS + 63) / 64;
constexpr float LOG2E = 1.4426950408889634f;
constexpr int MODN = 14 * D;
static_assert(SEQ % 256 == 0 && PAST % 128 == 0 && NPC_P <= 128 && NPC_S <= 128 && NSELB_P <= 32 && NSELB_S <= 33 && DFF % 64 == 0, "cfg");

typedef unsigned short bf16_t;
typedef short bf16x8 __attribute__((ext_vector_type(8)));
typedef short bf16x4 __attribute__((ext_vector_type(4)));
typedef float f32x4 __attribute__((ext_vector_type(4)));
typedef float f32x2 __attribute__((ext_vector_type(2)));
typedef unsigned u32x4 __attribute__((ext_vector_type(4)));
typedef unsigned u32x2 __attribute__((ext_vector_type(2)));
#define DI __device__ __forceinline__

#ifdef EMU
#define MFMA16(a, b, c) emu_mfma_16x16x32_bf16((a), (b), (c))
#define LAUNCH(kern, grid, block, lds, stream, ...) emu_launch(dim3(grid), dim3(block), lds, [=]() { kern(__VA_ARGS__); })
#define WAVE_SYNC() (void)__ballot(1)
#define OPAQUE(x) ((void)0)
#define UNIFORM(x) (x)
DI char* lds_base() { return (char*)emu_cur->blk->lds; }
#else
#define MFMA16(a, b, c) __builtin_amdgcn_mfma_f32_16x16x32_bf16((a), (b), (c), 0, 0, 0)
#define LAUNCH(kern, grid, block, lds, stream, ...) hipLaunchKernelGGL(kern, dim3(grid), dim3(block), lds, stream, __VA_ARGS__)
#define WAVE_SYNC() do { asm volatile("s_waitcnt lgkmcnt(0)" ::: "memory"); __builtin_amdgcn_wave_barrier(); asm volatile("" ::: "memory"); } while (0)
#define OPAQUE(x) asm volatile("" : "+v"(x))
#define UNIFORM(x) __builtin_amdgcn_readfirstlane(x)
extern __shared__ __attribute__((aligned(16))) char dyn_lds_[];
DI char* lds_base() { return dyn_lds_; }
#endif

DI bf16_t f2bf(float x) { unsigned u = __float_as_uint(x); u += 0x7fffu + ((u >> 16) & 1u); return (bf16_t)(u >> 16); }
DI float bf2f(bf16_t h) { return __uint_as_float(((unsigned)h) << 16); }
#ifdef EMU
DI unsigned pack2(float lo, float hi) { return (unsigned)f2bf(lo) | ((unsigned)f2bf(hi) << 16); }
#else
DI unsigned pack2(float lo, float hi) { unsigned r; asm("v_cvt_pk_bf16_f32 %0, %1, %2" : "=v"(r) : "v"(lo), "v"(hi)); return r; }
#endif
DI bf16x4 pack4(f32x4 v) { u32x2 r; r.x = pack2(v.x, v.y); r.y = pack2(v.z, v.w); return __builtin_bit_cast(bf16x4, r); }
DI bf16x8 pack8(f32x4 a, f32x4 b) { u32x4 r; r.x = pack2(a.x, a.y); r.y = pack2(a.z, a.w); r.z = pack2(b.x, b.y); r.w = pack2(b.z, b.w); return __builtin_bit_cast(bf16x8, r); }
DI f32x4 unpack4(bf16x4 v) { f32x4 r; for (int e = 0; e < 4; ++e) r[e] = bf2f((bf16_t)v[e]); return r; }
DI bf16x8 cat4(bf16x4 a, bf16x4 b) { return __builtin_shufflevector(a, b, 0, 1, 2, 3, 4, 5, 6, 7); }
#ifdef EMU
template <int N> DI float dpp_ror(float v) { const int lane = threadIdx.x & 63; return __shfl(v, (lane & ~15) | ((lane - N) & 15)); }
template <int N> DI float dpp_shr(float cur, float old) { const int lane = threadIdx.x & 63; const float t = __shfl(cur, (lane - N) & 63); return (lane & 15) >= N ? t : old; }
#else
template <int N> DI float dpp_ror(float v) { return __builtin_bit_cast(float, __builtin_amdgcn_update_dpp(0, __builtin_bit_cast(int, v), 0x120 + N, 0xf, 0xf, false)); }
template <int N> DI float dpp_shr(float cur, float old) { return __builtin_bit_cast(float, __builtin_amdgcn_update_dpp(__builtin_bit_cast(int, old), __builtin_bit_cast(int, cur), 0x110 + N, 0xf, 0xf, false)); }
#endif
DI float siluf(float x) { return x / (1.0f + __expf(-x)); }
#ifdef EMU
DI float silu_fast(float x) { return x / (1.0f + __expf(-x)); }
#else
DI float silu_fast(float x) { return x * __builtin_amdgcn_rcpf(1.0f + __builtin_amdgcn_exp2f(-1.4426950408889634f * x)); }
#endif
DI float sigmoidf(float x) { return 1.0f / (1.0f + __expf(-x)); }
#ifdef EMU
DI float sigmoid_fast(float x) { return 1.0f / (1.0f + __expf(-x)); }
#else
DI float sigmoid_fast(float x) { return __builtin_amdgcn_rcpf(1.0f + __builtin_amdgcn_exp2f(-1.4426950408889634f * x)); }
#endif
DI float wave_sum(float v) { v += __shfl_xor(v, 1); v += __shfl_xor(v, 2); v += __shfl_xor(v, 4); v += __shfl_xor(v, 8); v += __shfl_xor(v, 16); v += __shfl_xor(v, 32); return v; }
DI float wave_max(float v) { v = fmaxf(v, __shfl_xor(v, 1)); v = fmaxf(v, __shfl_xor(v, 2)); v = fmaxf(v, __shfl_xor(v, 4)); v = fmaxf(v, __shfl_xor(v, 8)); v = fmaxf(v, __shfl_xor(v, 16)); v = fmaxf(v, __shfl_xor(v, 32)); return v; }

#ifdef EMU
struct XcdBarrier { int dummy; };
#define XCD_BAR_WORDS 3456
DI void grid_barrier(const XcdBarrier&) { emu_grid_barrier(); }
#else
#define XB_TMO      128
#define XB_XCNT(j)  (256  + 64 * (j))
#define XB_XSUB(j)  (1280 + 64 * (j))
#define XB_XGEN(j)  (2304 + 64 * (j))
#define XB_TOP      3328
#define XB_TOPGEN   3392
#define XCD_BAR_WORDS 3456
#define XB_SPIN_CAP (1u << 22)
#define LAS __attribute__((address_space(3)))
__device__ __forceinline__ unsigned xb_ld(unsigned* p)              { return __hip_atomic_load(p, __ATOMIC_RELAXED, __HIP_MEMORY_SCOPE_AGENT); }
__device__ __forceinline__ unsigned xb_add(unsigned* p, unsigned v) { return __hip_atomic_fetch_add(p, v, __ATOMIC_RELAXED, __HIP_MEMORY_SCOPE_AGENT); }
__device__ __forceinline__ unsigned xb_xcc_id() { return (unsigned)__builtin_amdgcn_s_getreg((3 << 11) | 20) & 0xFu; }
#define XB_SPIN(cond, bar) do { unsigned _sp = 0; while (cond) { __builtin_amdgcn_s_sleep(1); \
    if ((++_sp & 255u) == 0u) { if (xb_ld(&(bar)[XB_TMO])) break; if (_sp > XB_SPIN_CAP) { atomicAdd(&(bar)[XB_TMO], 1u); break; } } } } while (0)
struct XcdBarrier { unsigned* bar; unsigned x; volatile LAS unsigned* st; };
__device__ __forceinline__ XcdBarrier xcd_barrier_post(unsigned* bar, volatile LAS unsigned* st) {
    XcdBarrier b; b.bar = bar; b.x = xb_xcc_id(); b.st = st;
    if (threadIdx.x == 0) (void)xb_add(&bar[XB_XCNT(b.x)], 1u);
    return b;
}
__device__ __forceinline__ void xcd_barrier_complete(unsigned* bar, unsigned x, unsigned& nloc, unsigned& nx) {
    const unsigned G = gridDim.x * gridDim.y * gridDim.z;
    unsigned sum, cnt, mine, sp = 0u;
    for (;;) {
        sum = 0u; cnt = 0u; mine = 0u;
#pragma unroll
        for (unsigned j = 0; j < 16; ++j) { const unsigned c = xb_ld(&bar[XB_XCNT(j)]); sum += c; cnt += (c > 0u) ? 1u : 0u; mine = (j == x) ? c : mine; }
        if (sum == G) break;
        __builtin_amdgcn_s_sleep(1);
        if ((++sp & 255u) == 0u) { if (xb_ld(&bar[XB_TMO])) break; if (sp > XB_SPIN_CAP) { atomicAdd(&bar[XB_TMO], 1u); break; } }
    }
    nloc = mine > 0u ? mine : 1u; nx = cnt > 0u ? cnt : 1u;
}
__device__ __forceinline__ void xcd_barrier(const XcdBarrier& b) {
    asm volatile("s_waitcnt vmcnt(0)" ::: "memory");
    __syncthreads();
    if (threadIdx.x == 0) {
        unsigned* bar = b.bar;
        __builtin_amdgcn_s_waitcnt(0);
        unsigned nloc = b.st[0], nx = b.st[1];
        if (nloc == 0u) { xcd_barrier_complete(bar, b.x, nloc, nx); b.st[0] = nloc; b.st[1] = nx; }
        const unsigned old = xb_add(&bar[XB_XSUB(b.x)], 1u);
        const unsigned gen = old / nloc;
        if (old + 1u == (gen + 1u) * nloc) {
            __builtin_amdgcn_fence(__ATOMIC_RELEASE, "agent");
            asm volatile("s_waitcnt vmcnt(0)" ::: "memory");
            const unsigned og = xb_add(&bar[XB_TOP], 1u);
            const unsigned tg = og / nx;
            if (og + 1u == (tg + 1u) * nx) xb_add(&bar[XB_TOPGEN], 1u);
            else XB_SPIN(xb_ld(&bar[XB_TOPGEN]) == tg, bar);
            __builtin_amdgcn_fence(__ATOMIC_ACQUIRE, "agent");
            xb_add(&bar[XB_XGEN(b.x)], 1u);
            asm volatile("s_waitcnt vmcnt(0)" ::: "memory");
        } else {
            XB_SPIN(xb_ld(&bar[XB_XGEN(b.x)]) == gen, bar);
            __builtin_amdgcn_fence(__ATOMIC_ACQUIRE, "agent");
            asm volatile("s_waitcnt vmcnt(0)" ::: "memory");
        }
    }
    __syncthreads();
}
DI void grid_barrier(const XcdBarrier& b) { xcd_barrier(b); }
#endif

struct Params {
    const float *x_prompt, *x_sample, *c_prompt, *c_sample, *state_ret, *state_conv, *cache_kv, *state_win;
    const int* page_table;
    const float *w_ada, *b_ada, *g_mix, *g_ffn, *w_ffn_in, *conv_w, *conv_b, *w_ffn_out, *w_ret_in, *w_ret_out, *g_kv, *w_ada_kv, *b_ada_kv, *w_kv,
        *pe_ck, *pe_cv, *w_ck1, *w_ck2, *w_cv1, *w_cv2, *w_nsa_in, *w_nsa_out, *g_final;
    float *y_prompt, *y_sample, *ret_prompt, *ret_sample, *conv_prompt, *conv_sample, *kv_prompt, *kv_sample, *win_prompt, *win_sample;
    unsigned* bar;
    bf16_t *Wada, *Wret_in, *Wret_out, *Wffn_in, *Wffn_out, *Wkv, *Wnsa_in, *Wnsa_out, *Wc1, *Wc2;
    float *cbias, *mod, *ssq, *gates, *aof; bf16_t *Z1, *X;
    bf16_t *Acmp, *scb, *hbuf, *hkv, *qb, *kb, *vb, *sgb, *kT, *vT, *obuf, *actr, *u, *actf, *kvb, *vTs, *vTw, *kc, *vcT, *ao, *uh;
    int ph_lo, ph_hi;
};

struct WsAlloc { size_t off = 0; template <class T> T* take(void* base, size_t n) { T* p = (T*)((char*)base + off); off += (n * sizeof(T) + 255) & ~(size_t)255; return p; } };

constexpr int GBM = 256, GBN = 128, GBK = 64, GPITCH = 72;
constexpr int GEMM_LDS = (GBM + GBN) * GPITCH * 2;
struct LoadRowMajor { const bf16_t* A; int lda; DI bf16x8 operator()(int row, int k0) const { return *(const bf16x8*)(A + (size_t)row * lda + k0); } };

template <bool TRANS, class LoadA, class Epi>
DI void gemm_phase(int M, int N, int K, const bf16_t* __restrict__ Bt, const LoadA& loadA, const Epi& epi, char* lds) {
    bf16_t* As = (bf16_t*)lds; bf16_t* Bs = As + GBM * GPITCH;
    const int tid = threadIdx.x, lane = tid & 63, w = tid >> 6, wm = w >> 1, wn = w & 1, l15 = lane & 15, q = lane >> 4;
    const int nM = (M + GBM - 1) / GBM, nN = N / GBN, nK = K / GBK;
    for (int tile = blockIdx.x; tile < nM * nN; tile += gridDim.x) {
        const int tm = tile / nN, tn = tile % nN;
        const int arow0 = tm * GBM, brow0 = tn * GBN;
        f32x4 acc[4][4];
#pragma unroll
        for (int i = 0; i < 4; ++i)
#pragma unroll
            for (int j = 0; j < 4; ++j) acc[i][j] = (f32x4){0.f, 0.f, 0.f, 0.f};
        bf16x8 pa[4], pb[2];
        int ar[4], ak[4];
#pragma unroll
        for (int i = 0; i < 4; ++i) { const int c = tid + 512 * i; ar[i] = c >> 3; ak[i] = (c & 7) * 8; }
#pragma unroll
        for (int i = 0; i < 4; ++i) { int r = arow0 + ar[i]; r = r < M ? r : M - 1; pa[i] = loadA(r, ak[i]); }
#pragma unroll
        for (int i = 0; i < 2; ++i) pb[i] = *(const bf16x8*)(Bt + (size_t)(brow0 + ar[i]) * K + ak[i]);
        for (int kt = 0; kt < nK; ++kt) {
            __syncthreads();
#pragma unroll
            for (int i = 0; i < 4; ++i) *(bf16x8*)(As + ar[i] * GPITCH + ak[i]) = pa[i];
#pragma unroll
            for (int i = 0; i < 2; ++i) *(bf16x8*)(Bs + ar[i] * GPITCH + ak[i]) = pb[i];
            __syncthreads();
            if (kt + 1 < nK) {
                const int k0 = (kt + 1) * GBK;
#pragma unroll
                for (int i = 0; i < 4; ++i) { int r = arow0 + ar[i]; r = r < M ? r : M - 1; pa[i] = loadA(r, k0 + ak[i]); }
#pragma unroll
                for (int i = 0; i < 2; ++i) pb[i] = *(const bf16x8*)(Bt + (size_t)(brow0 + ar[i]) * K + k0 + ak[i]);
            }
#pragma unroll
            for (int ks = 0; ks < 2; ++ks) {
                bf16x8 a[4], b[4];
#pragma unroll
                for (int i = 0; i < 4; ++i) a[i] = *(const bf16x8*)(As + (wm * 64 + i * 16 + l15) * GPITCH + ks * 32 + q * 8);
#pragma unroll
                for (int j = 0; j < 4; ++j) b[j] = *(const bf16x8*)(Bs + (wn * 64 + j * 16 + l15) * GPITCH + ks * 32 + q * 8);
#pragma unroll
                for (int i = 0; i < 4; ++i)
#pragma unroll
                    for (int j = 0; j < 4; ++j) acc[i][j] = TRANS ? MFMA16(b[j], a[i], acc[i][j]) : MFMA16(a[i], b[j], acc[i][j]);
            }
        }
#pragma unroll
        for (int i = 0; i < 4; ++i)
#pragma unroll
            for (int j = 0; j < 4; ++j) {
                if (TRANS) { const int m = arow0 + wm * 64 + i * 16 + l15, n = brow0 + wn * 64 + j * 16 + 4 * q; if (m < M) epi(m, n, acc[i][j]); }
                else { const int m = arow0 + wm * 64 + i * 16 + 4 * q, n = brow0 + wn * 64 + j * 16 + l15; if (m < M) epi(m, n, acc[i][j]); }
            }
    }
}

#ifndef EMU
namespace pg8 {
#define PG8_LAS __attribute__((address_space(3)))
typedef unsigned short bf16_t;
typedef short bf16x8 __attribute__((ext_vector_type(8)));
typedef float f32x4 __attribute__((ext_vector_type(4)));
typedef unsigned u32x4 __attribute__((ext_vector_type(4)));
constexpr int BM = 256, BK = 64, HALF = 128, HTB = HALF * BK * 2  , STAGE_BYTES = 8 * HTB, NXCD = 8, WGM = 8;

__host__ __device__ __forceinline__ int lds_byte(int r, int c) { const int st = (r >> 4) * 2 + (c >> 5), rr = r & 15, cc = c & 31, ob = rr * 64 + cc * 2; return st * 1024 + (ob ^ (((ob >> 9) & 1) << 5)); }
__host__ __device__ __forceinline__ void stage_rc(int b, int& R, int& C) { const int st = b / 1024, sb = b % 1024, swz = sb ^ (((sb >> 9) & 1) << 5); R = (st >> 1) * 16 + swz / 64; C = (st & 1) * 32 + (swz % 64) / 2; }
__host__ __device__ __forceinline__ int perm32(int rho) { const int n = rho >> 4, i = rho & 15; return 8 * (i >> 2) + 4 * n + (i & 3); }

struct Unit { int pm, pn; };
struct Gemm { const bf16_t* A; const bf16_t* Bt; int M, N, K; const bf16_t* A2 = nullptr; const bf16_t* Bt2 = nullptr; int nN0 = 1 << 30; };

struct StaticOrder {
    int nM, nN, nwg, G, c;
    __host__ __device__ void init(int M, int N, int G_, int c_) { nM = M / BM; nN = N / BM; nwg = nM * nN; G = G_; c = c_; }
    __host__ __device__ bool next(int i, Unit& u) const {
        const long L = (long)i * G + c; if (L >= nwg) return false;
        int wgid = (int)L; { const int q = nwg / NXCD, r = nwg % NXCD, xcd = wgid % NXCD, off = wgid / NXCD; wgid = (xcd < r ? xcd * (q + 1) : r * (q + 1) + (xcd - r) * q) + off; }
        const int nig = WGM * nN, gid = wgid / nig, fm = gid * WGM, gsz = (nM - fm) < WGM ? (nM - fm) : WGM;
        u.pm = fm + ((wgid % nig) % gsz); u.pn = (wgid % nig) / gsz; return true;
    }
    __device__ __forceinline__ void a_ready(const Unit&) const {}
    __device__ __forceinline__ void done(const Unit&) const {}
};

template <class Epi, class Sched, bool STAMP = false>
__device__ __forceinline__ void gemm_phase(PG8_LAS unsigned char* lds, const Gemm g, const Sched& S, const Epi& E, unsigned long long* stamps) {
    const int tid = threadIdx.x, wid = __builtin_amdgcn_readfirstlane(tid >> 6), lane = tid & 63, wr = wid >> 2, wc = wid & 3, fr = lane & 15, fq = lane >> 4;
    const int K = g.K, nt = K / BK;
    int ts_lo = 0, ts_hi = 0, nts = 0; const unsigned long long rt_entry = STAMP ? (unsigned long long)wall_clock64() : 0ull;
#define PG8_STAMP() do { if (STAMP && wid == 0 && nts < 64) { const unsigned long long _c = (unsigned long long)clock64(); \
        ts_lo = (lane == nts) ? (int)(unsigned)_c : ts_lo; ts_hi = (lane == nts) ? (int)(unsigned)(_c >> 32) : ts_hi; ++nts; } } while (0)
    PG8_STAMP();
    unsigned voffA[2], voffB[2];
#pragma unroll
    for (int i = 0; i < 2; ++i) { int R, C; stage_rc(tid * 16 + i * 8192, R, C); const int Rb = Epi::PERM ? ((R & ~31) + perm32(R & 31)) : R;
        voffA[i] = (unsigned)(R * K + C) * 2u; voffB[i] = (unsigned)(Rb * K + C) * 2u; }
    const size_t kstep = (size_t)(BK * 2);
    const size_t hstep = (size_t)HALF * K * 2;
    const size_t tstep = 2 * hstep;
    const unsigned ldsw = (unsigned)wid * 1024u;
    const int aoff = lds_byte(wr * 64 + fr, fq * 8), boff = lds_byte(wc * 32 + fr, fq * 8);
#define PG8_SA(b, h) (((b) * 2 + (h)) * HTB)
#define PG8_SB(b, h) ((4 + (b) * 2 + (h)) * HTB)
#define PG8_STAGE(bufoff, gbase, voff) do { _Pragma("unroll") for (int _i = 0; _i < 2; ++_i) \
        __builtin_amdgcn_global_load_lds((const unsigned*)((const char*)(gbase) + (voff)[_i]), (PG8_LAS unsigned*)(lds + (bufoff) + ldsw + _i * 8192), 16, 0, 0); } while (0)
#define PG8_LDA(dst, b, h) do { _Pragma("unroll") for (int m = 0; m < 4; ++m) _Pragma("unroll") for (int k = 0; k < 2; ++k) dst[m][k] = *(const PG8_LAS bf16x8*)(lds + PG8_SA(b, h) + aoff + m * 2048 + k * 1024); } while (0)
#define PG8_LDB(dst, b, h) do { _Pragma("unroll") for (int n = 0; n < 2; ++n) _Pragma("unroll") for (int k = 0; k < 2; ++k) dst[n][k] = *(const PG8_LAS bf16x8*)(lds + PG8_SB(b, h) + boff + n * 2048 + k * 1024); } while (0)
#define PG8_MMA(ai, bj, At, Bt) do { __builtin_amdgcn_s_setprio(1); _Pragma("unroll") for (int m = 0; m < 4; ++m) _Pragma("unroll") for (int n = 0; n < 2; ++n) _Pragma("unroll") for (int k = 0; k < 2; ++k) \
        acc[ai][bj][m][n] = __builtin_amdgcn_mfma_f32_16x16x32_bf16(Bt[n][k], At[m][k], acc[ai][bj][m][n], 0, 0, 0); __builtin_amdgcn_s_setprio(0); } while (0)
#define PG8_WAIT_V(n) asm volatile("s_waitcnt vmcnt(" #n ")" ::: "memory")
#define PG8_WAIT_L(n) asm volatile("s_waitcnt lgkmcnt(" #n ")" ::: "memory")
#define PG8_BAR __builtin_amdgcn_s_barrier()
#define PG8_SCHED __builtin_amdgcn_sched_barrier(0)
    Unit cur, nxt; int ui = 0;
    if (!S.next(0, cur)) return;
    f32x4 acc[2][2][4][2];
#pragma unroll
    for (int a = 0; a < 2; ++a)
#pragma unroll
        for (int b = 0; b < 2; ++b)
#pragma unroll
            for (int m = 0; m < 4; ++m)
#pragma unroll
                for (int n = 0; n < 2; ++n) acc[a][b][m][n] = (f32x4){0.f, 0.f, 0.f, 0.f};
    bf16x8 At[4][2], B0[2][2], B1[2][2];
    const char* cA = (const char*)(cur.pn < g.nN0 ? g.A : g.A2) + (size_t)cur.pm * tstep; const char* cB = cur.pn < g.nN0 ? (const char*)g.Bt + (size_t)cur.pn * tstep : (const char*)g.Bt2 + (size_t)(cur.pn - g.nN0) * tstep;
    S.a_ready(cur);
    PG8_STAGE(PG8_SB(0, 0), cB, voffB); PG8_STAGE(PG8_SA(0, 0), cA, voffA); PG8_STAGE(PG8_SB(0, 1), cB + hstep, voffB); PG8_STAGE(PG8_SA(0, 1), cA + hstep, voffA);
    if (wr == 1) PG8_BAR;
    PG8_WAIT_V(4); PG8_BAR;
    PG8_STAGE(PG8_SB(1, 0), cB + kstep, voffB); PG8_STAGE(PG8_SA(1, 0), cA + kstep, voffA); PG8_STAGE(PG8_SB(1, 1), cB + hstep + kstep, voffB);
    PG8_WAIT_V(6); PG8_BAR;
    PG8_STAMP();
    for (;;) {
        const bool has_next = S.next(ui + 1, nxt);
        const char* nA = has_next ? (const char*)(nxt.pn < g.nN0 ? g.A : g.A2) + (size_t)nxt.pm * tstep : cA; const char* nB = has_next ? (nxt.pn < g.nN0 ? (const char*)g.Bt + (size_t)nxt.pn * tstep : (const char*)g.Bt2 + (size_t)(nxt.pn - g.nN0) * tstep) : cB;
        for (int t = 0; t < nt; t += 2) {
            const bool last = (t == nt - 2);
            const char* a1 = cA + (size_t)(t + 1) * kstep;
            const char* a2 = last ? nA : cA + (size_t)(t + 2) * kstep; const char* b2 = last ? nB : cB + (size_t)(t + 2) * kstep;
            const char* a3 = a2 + kstep; const char* b3 = b2 + kstep;
            if (last && has_next) S.a_ready(nxt);
            PG8_LDB(B0, 0, 0); PG8_SCHED; PG8_LDA(At, 0, 0); PG8_STAGE(PG8_SA(1, 1), a1 + hstep, voffA);
            PG8_WAIT_L(8); PG8_BAR; PG8_WAIT_L(0); PG8_MMA(0, 0, At, B0); PG8_BAR; PG8_SCHED;
            PG8_LDB(B1, 0, 1); PG8_STAGE(PG8_SB(0, 0), b2, voffB);
            PG8_BAR; PG8_WAIT_L(0); PG8_MMA(0, 1, At, B1); PG8_BAR;
            PG8_LDA(At, 0, 1); PG8_STAGE(PG8_SA(0, 0), a2, voffA);
            PG8_BAR; PG8_WAIT_L(0); PG8_MMA(1, 0, At, B0); PG8_BAR; PG8_SCHED;
            PG8_STAGE(PG8_SB(0, 1), b2 + hstep, voffB);
            PG8_WAIT_V(6); PG8_BAR; PG8_MMA(1, 1, At, B1); PG8_BAR;
            PG8_LDB(B0, 1, 0); PG8_SCHED; PG8_LDA(At, 1, 0); PG8_STAGE(PG8_SA(0, 1), a2 + hstep, voffA);
            PG8_WAIT_L(8); PG8_BAR; PG8_WAIT_L(0); PG8_MMA(0, 0, At, B0); PG8_BAR; PG8_SCHED;
            PG8_LDB(B1, 1, 1); PG8_STAGE(PG8_SB(1, 0), b3, voffB);
            PG8_BAR; PG8_WAIT_L(0); PG8_MMA(0, 1, At, B1); PG8_BAR;
            PG8_LDA(At, 1, 1); PG8_STAGE(PG8_SA(1, 0), a3, voffA);
            PG8_BAR; PG8_WAIT_L(0); PG8_MMA(1, 0, At, B0); PG8_BAR; PG8_SCHED;
            PG8_STAGE(PG8_SB(1, 1), b3 + hstep, voffB);
            PG8_WAIT_V(6); PG8_BAR; PG8_MMA(1, 1, At, B1); PG8_BAR;
        }
        PG8_STAMP();
        if constexpr (!Epi::AFTER_DRAIN) { E(acc, cur, wr, wc, fr, fq); S.done(cur); }
        PG8_STAMP();
        if (!has_next) break;
#pragma unroll
        for (int a = 0; a < 2; ++a)
#pragma unroll
            for (int b = 0; b < 2; ++b)
#pragma unroll
                for (int m = 0; m < 4; ++m)
#pragma unroll
                    for (int n = 0; n < 2; ++n) acc[a][b][m][n] = (f32x4){0.f, 0.f, 0.f, 0.f};
        cur = nxt; cA = nA; cB = nB; ++ui;
    }
    PG8_WAIT_V(0);
    if (wr == 0) PG8_BAR;
    PG8_BAR;
    if constexpr (Epi::AFTER_DRAIN) { E.fused(acc, cur, wr, wc, fr, fq, lds, wid, lane); S.done(cur); }
    PG8_STAMP();
    if (STAMP && wid == 0) { stamps[lane] = lane < nts ? (((unsigned long long)(unsigned)ts_hi << 32) | (unsigned)ts_lo) : 0ull;
        if (lane == 62) stamps[62] = rt_entry; if (lane == 63) stamps[63] = (unsigned long long)wall_clock64(); }
#undef PG8_STAMP
#undef PG8_SA
#undef PG8_SB
#undef PG8_STAGE
#undef PG8_LDA
#undef PG8_LDB
#undef PG8_MMA
#undef PG8_WAIT_V
#undef PG8_WAIT_L
#undef PG8_BAR
#undef PG8_SCHED
}
}
#else
namespace pg8 {
typedef ::f32x4 f32x4;
struct Unit { int pm, pn; };
struct Gemm { const bf16_t* A; const bf16_t* Bt; int M, N, K; const bf16_t* A2 = nullptr; const bf16_t* Bt2 = nullptr; int nN0 = 1 << 30; };
inline int perm32(int rho) { const int n = rho >> 4, i = rho & 15; return 8 * (i >> 2) + 4 * n + (i & 3); }
template <class Epi> inline void gemm_phase_emu(const Gemm g, const Epi& E, int rot) {
    const int tid = threadIdx.x, lane = tid & 63, wid = tid >> 6, wr = wid >> 2, wc = wid & 3, fr = lane & 15, fq = lane >> 4;
    const int nM = g.M / 256, nN = g.N / 256;
    for (int L = (int)((blockIdx.x + rot) % gridDim.x); L < nM * nN; L += gridDim.x) {
        Unit u{L / nN, L % nN};
        f32x4 acc[2][2][4][2];
        for (int a = 0; a < 2; ++a) for (int b = 0; b < 2; ++b) for (int m = 0; m < 4; ++m) for (int n = 0; n < 2; ++n) acc[a][b][m][n] = (f32x4){0.f, 0.f, 0.f, 0.f};
        for (int kk = 0; kk < g.K / 32; ++kk)
            for (int a = 0; a < 2; ++a) for (int m = 0; m < 4; ++m) {
                const bf16x8 af = *(const bf16x8*)((u.pn < g.nN0 ? g.A : g.A2) + (size_t)(u.pm * 256 + a * 128 + wr * 64 + m * 16 + fr) * g.K + kk * 32 + fq * 8);
                for (int b = 0; b < 2; ++b) for (int n = 0; n < 2; ++n) {
                    const int rho = 16 * n + fr, cw = Epi::PERM ? perm32(rho) : rho;
                    const bf16x8 bf = *(const bf16x8*)((u.pn < g.nN0 ? g.Bt + (size_t)(u.pn * 256) * g.K : g.Bt2 + (size_t)((u.pn - g.nN0) * 256) * g.K) + (size_t)(b * 128 + wc * 32 + cw) * g.K + kk * 32 + fq * 8);
                    acc[a][b][m][n] = MFMA16(bf, af, acc[a][b][m][n]);
                }
            }
        E(acc, u, wr, wc, fr, fq);
    }
}
}
#endif
template <class Epi> struct Pg8Epi {
    static constexpr bool PERM = Epi::WIDE8, AFTER_DRAIN = false;
    const Epi* e; int M;
    __device__ __forceinline__ void operator()(const pg8::f32x4 (&acc)[2][2][4][2], const pg8::Unit& u, int wr, int wc, int fr, int fq) const {
#pragma unroll
        for (int ai = 0; ai < 2; ++ai)
#pragma unroll
            for (int m = 0; m < 4; ++m) {
                const int row = u.pm * 256 + ai * 128 + wr * 64 + m * 16 + fr;
                if (row < M) {
#pragma unroll
                    for (int bj = 0; bj < 2; ++bj) {
                        if constexpr (Epi::WIDE8) e->wide(row, u.pn * 256 + bj * 128 + wc * 32 + 8 * fq, acc[ai][bj][m][0], acc[ai][bj][m][1]);
                        else {
#pragma unroll
                            for (int n = 0; n < 2; ++n) (*e)(row, u.pn * 256 + bj * 128 + wc * 32 + n * 16 + 4 * fq, acc[ai][bj][m][n]);
                        }
                    }
                }
            }
    }
};
template <class PgEpi>
DI void big_gemm_raw(int M, int N, int K, const bf16_t* A, const bf16_t* Bt, const PgEpi& E, char* lds, int rot = 0) {
    pg8::Gemm g{A, Bt, (M + 255) / 256 * 256, N, K};
#ifdef EMU
    pg8::gemm_phase_emu(g, E, rot);
#else
    pg8::StaticOrder S; S.init(g.M, N, (int)gridDim.x, (int)((blockIdx.x + rot) % gridDim.x));
    pg8::gemm_phase<PgEpi, pg8::StaticOrder, false>((PG8_LAS unsigned char*)lds, g, S, E, nullptr);
#endif
}
template <class Epi0, class Epi1> struct Pg8Epi2 {
    static constexpr bool PERM = false, AFTER_DRAIN = false;
    const Epi0* e0; const Epi1* e1; int M, nN0;
    __device__ __forceinline__ void operator()(const pg8::f32x4 (&acc)[2][2][4][2], const pg8::Unit& u, int wr, int wc, int fr, int fq) const {
        const bool first = u.pn < nN0; const int cbase = (first ? u.pn : u.pn - nN0) * 256;
#pragma unroll
        for (int ai = 0; ai < 2; ++ai)
#pragma unroll
            for (int m = 0; m < 4; ++m) {
                const int row = u.pm * 256 + ai * 128 + wr * 64 + m * 16 + fr;
                if (row < M) {
#pragma unroll
                    for (int bj = 0; bj < 2; ++bj)
#pragma unroll
                        for (int n = 0; n < 2; ++n) { const int col = cbase + bj * 128 + wc * 32 + n * 16 + 4 * fq; if (first) (*e0)(row, col, acc[ai][bj][m][n]); else (*e1)(row, col, acc[ai][bj][m][n]); }
                }
            }
    }
};
template <class Epi0, class Epi1>
DI void big_gemm2(int M, int K, const bf16_t* A0, const bf16_t* Bt0, int N0, const Epi0& e0, const bf16_t* A1, const bf16_t* Bt1, int N1, const Epi1& e1, char* lds) {
    Pg8Epi2<Epi0, Epi1> E{&e0, &e1, M, N0 / 256};
    pg8::Gemm g{A0, Bt0, (M + 255) / 256 * 256, N0 + N1, K, A1, Bt1, N0 / 256};
#ifdef EMU
    pg8::gemm_phase_emu(g, E, 0);
#else
    pg8::StaticOrder S; S.init(g.M, g.N, (int)gridDim.x, (int)blockIdx.x);
    pg8::gemm_phase<Pg8Epi2<Epi0, Epi1>, pg8::StaticOrder, false>((PG8_LAS unsigned char*)lds, g, S, E, nullptr);
#endif
}
template <class Epi>
DI void big_gemm(int M, int N, int K, const bf16_t* A, const bf16_t* Bt, const Epi& epi, char* lds, int rot = 0) {
    Pg8Epi<Epi> E{&epi, M};
    big_gemm_raw(M, N, K, A, Bt, E, lds, rot);
}

DI void gemm_cmp_sample(const Params& p, int c, const bf16_t* __restrict__ Wt, bf16_t* __restrict__ Zout, char* lds) {
    constexpr int PA = 72;
    bf16_t* As = (bf16_t*)lds; bf16_t* Bs = As + 128 * PA;
    const int tid = threadIdx.x, lane = tid & 63, w = tid >> 6, wm = w >> 2, wn = w & 3, l15 = lane & 15, q = lane >> 4;
    constexpr int NTILE = CROWS_S / 128;
    static_assert(CROWS_S % 128 == 0, "sample compress rows");
    for (int tile = blockIdx.x; tile < NTILE; tile += gridDim.x) {
        const int r0 = tile * 128;
        const float* abase[2]; unsigned boff[4];
#pragma unroll
        for (int i = 0; i < 2; ++i) { const int cc = tid + 512 * i, r = r0 + (cc >> 3), g = r & 3, j = (r >> 2) % NPC_S, bs = (r >> 2) / NPC_S;
            abase[i] = p.cache_kv + ((size_t)p.page_table[bs * NPAGES + (j >> 3)] * PAGE + ((16 * j) & 127)) * 1024 + c * 256 + g * 64 + (cc & 7) * 8; }
#pragma unroll
        for (int i = 0; i < 4; ++i) { const int cc = tid + 512 * i; boff[i] = (unsigned)((cc >> 3) * 1024 + (cc & 7) * 8); }
        f32x4 ra[2][2][2]; bf16x8 rb[4];
#pragma unroll
        for (int st = 0; st < 2; ++st)
#pragma unroll
            for (int i = 0; i < 2; ++i) { ra[st][i][0] = *(const f32x4*)(abase[i] + st * 1024); ra[st][i][1] = *(const f32x4*)(abase[i] + st * 1024 + 4); }
#pragma unroll
        for (int i = 0; i < 4; ++i) rb[i] = *(const bf16x8*)(Wt + boff[i]);
        f32x4 acc[4][4];
#pragma unroll
        for (int i = 0; i < 4; ++i)
#pragma unroll
            for (int j = 0; j < 4; ++j) acc[i][j] = (f32x4){0.f, 0.f, 0.f, 0.f};
#pragma unroll 1
        for (int kt2 = 0; kt2 < 8; ++kt2) {
#pragma unroll
            for (int st = 0; st < 2; ++st) {
                const int kt = 2 * kt2 + st;
                __syncthreads();
#pragma unroll
                for (int i = 0; i < 2; ++i) { const int cc = tid + 512 * i; *(bf16x8*)(As + (cc >> 3) * PA + (cc & 7) * 8) = pack8(ra[st][i][0], ra[st][i][1]); }
#pragma unroll
                for (int i = 0; i < 4; ++i) { const int cc = tid + 512 * i; *(bf16x8*)(Bs + (cc >> 3) * PA + (cc & 7) * 8) = rb[i]; }
                __syncthreads();
                if (kt + 2 < 16) {
#pragma unroll
                    for (int i = 0; i < 2; ++i) { ra[st][i][0] = *(const f32x4*)(abase[i] + (kt + 2) * 1024); ra[st][i][1] = *(const f32x4*)(abase[i] + (kt + 2) * 1024 + 4); }
                }
                if (kt + 1 < 16) {
#pragma unroll
                    for (int i = 0; i < 4; ++i) rb[i] = *(const bf16x8*)(Wt + (boff[i] + (unsigned)((kt + 1) * 64)));
                }
#pragma unroll
                for (int ks = 0; ks < 2; ++ks) {
                    bf16x8 a[4], b[4];
#pragma unroll
                    for (int i = 0; i < 4; ++i) a[i] = *(const bf16x8*)(As + (wm * 64 + i * 16 + l15) * PA + ks * 32 + q * 8);
#pragma unroll
                    for (int j = 0; j < 4; ++j) b[j] = *(const bf16x8*)(Bs + (wn * 64 + j * 16 + l15) * PA + ks * 32 + q * 8);
#pragma unroll
                    for (int i = 0; i < 4; ++i)
#pragma unroll
                        for (int j = 0; j < 4; ++j) acc[i][j] = MFMA16(b[j], a[i], acc[i][j]);
                }
            }
        }
#pragma unroll
        for (int i = 0; i < 4; ++i)
#pragma unroll
            for (int j = 0; j < 4; ++j) *(bf16x4*)(Zout + (size_t)(r0 + wm * 64 + i * 16 + l15) * 256 + wn * 64 + j * 16 + 4 * q) = pack4(acc[i][j]);
    }
}

template <class Epi>
DI void gemm_wsplit(int m0, int M, int N, int K, const bf16_t* A, const bf16_t* Bt, const Epi& epi, char* lds) {
    float* red = (float*)lds;
    const int tid = threadIdx.x, lane = tid & 63, w = UNIFORM(tid >> 6), l15 = lane & 15, q = lane >> 4;
    const int nM = (M - m0 + 63) / 64, nN = N / 64, kw = K / 8, nks = kw / 32;
    for (int tile = blockIdx.x; tile < nM * nN; tile += gridDim.x) {
        const int r0 = m0 + (tile / nN) * 64, n0 = (tile % nN) * 64;
        f32x4 acc[4][4];
#pragma unroll
        for (int i = 0; i < 4; ++i)
#pragma unroll
            for (int j = 0; j < 4; ++j) acc[i][j] = (f32x4){0.f, 0.f, 0.f, 0.f};
        const bf16_t* ap[4]; const bf16_t* bp[4];
#pragma unroll
        for (int i = 0; i < 4; ++i) { int r = r0 + 16 * i + l15; r = r < M ? r : M - 1; ap[i] = A + (size_t)r * K + w * kw + q * 8; bp[i] = Bt + (size_t)(n0 + 16 * i + l15) * K + w * kw + q * 8; }
#pragma unroll 2
        for (int ks = 0; ks < nks; ++ks) {
            bf16x8 a[4], b[4];
#pragma unroll
            for (int i = 0; i < 4; ++i) { a[i] = *(const bf16x8*)(ap[i] + ks * 32); b[i] = *(const bf16x8*)(bp[i] + ks * 32); }
#pragma unroll
            for (int i = 0; i < 4; ++i)
#pragma unroll
                for (int j = 0; j < 4; ++j) acc[i][j] = MFMA16(b[j], a[i], acc[i][j]);
        }
        __syncthreads();
#pragma unroll
        for (int i = 0; i < 4; ++i)
#pragma unroll
            for (int j = 0; j < 4; ++j) *(f32x4*)(red + w * 4096 + (16 * i + l15) * 64 + 16 * j + 4 * q) = acc[i][j];
        __syncthreads();
        const int m = tid >> 3, n8 = (tid & 7) * 8;
        f32x4 v0 = (f32x4){0.f, 0.f, 0.f, 0.f}, v1 = v0;
#pragma unroll
        for (int ww = 0; ww < 8; ++ww) { v0 += *(const f32x4*)(red + ww * 4096 + m * 64 + n8); v1 += *(const f32x4*)(red + ww * 4096 + m * 64 + n8 + 4); }
        if (r0 + m < M) { epi(r0 + m, n0 + n8, v0); epi(r0 + m, n0 + n8 + 4, v1); }
    }
}

DI int tok_batch(int tok) { return tok < TP ? tok / SEQ : BATCH + (tok - TP) / DS; }
DI const float* x_in_row(const Params& p, int tok) { return tok < TP ? p.x_prompt + (size_t)tok * D : p.x_sample + (size_t)(tok - TP) * D; }

struct CvtJob { const float* src; bf16_t* dst; int K, N, ld; float scale; int slo, shi; int ilv; };
constexpr int NCVT = 16;
DI CvtJob cvt_job(const Params& p, int j) {
    CvtJob c; c.scale = 1.f; c.slo = 0; c.shi = 0; c.ilv = 0;
    switch (j) {
    case 0:  c = {p.w_ada, p.Wada, D, 6 * D, 6 * D, 1.f, 0, 0, 0}; break;
    case 1:  c = {p.w_ada + (size_t)D * 6 * D, p.Wada + (size_t)6 * D * D, D, 6 * D, 6 * D, 1.f, 0, 0, 0}; break;
    case 2:  c = {p.w_ada_kv, p.Wada + (size_t)12 * D * D, D, 2 * D, 2 * D, 1.f, 0, 0, 0}; break;
    case 3:  c = {p.w_ret_in, p.Wret_in, D, RETP, RETP, 0.0625f, NQ, 2 * NQ, 0}; break;
    case 4:  c = {p.w_ret_out, p.Wret_out, NV, D, D, 1.f, 0, 0, 0}; break;
    case 5:  c = {p.w_ffn_in, p.Wffn_in, D, F2, F2, 1.f, 0, 0, 1}; break;
    case 6:  c = {p.w_ffn_in + (size_t)D * F2, p.Wffn_in + (size_t)F2 * D, D, F2, F2, 1.f, 0, 0, 1}; break;
    case 7:  c = {p.w_ffn_out, p.Wffn_out, DFF, D, D, 1.f, 0, 0, 0}; break;
    case 8:  c = {p.w_ffn_out + (size_t)DFF * D, p.Wffn_out + (size_t)D * DFF, DFF, D, D, 1.f, 0, 0, 0}; break;
    case 9:  c = {p.w_kv, p.Wkv, D, NKV, NKV, 1.f, 0, 0, 0}; break;
    case 10: c = {p.w_nsa_in, p.Wnsa_in, D, NNSA, NNSA, 0.125f * LOG2E, 0, HB * DH, 0}; break;
    case 11: c = {p.w_nsa_out, p.Wnsa_out, D, D, D, 1.f, 0, 0, 0}; break;
    case 12: c = {p.w_ck1, p.Wc1, 1024, 128, 128, 1.f, 0, 0, 0}; break;
    case 13: c = {p.w_ck1 + 1024 * 128, p.Wc1 + 128 * 1024, 1024, 128, 128, 1.f, 0, 0, 0}; break;
    case 14: c = {p.w_cv1, p.Wc1 + 256 * 1024, 1024, 128, 128, 1.f, 0, 0, 0}; break;
    default: c = {p.w_cv1 + 1024 * 128, p.Wc1 + 384 * 1024, 1024, 128, 128, 1.f, 0, 0, 0}; break;
    }
    return c;
}
constexpr int CVT_TN = 256;
DI void cvt_locate(const Params& p, int t, CvtJob& c, int& k0, int& n0) {
    int j = 0, rem = t;
    for (;; ++j) { c = cvt_job(p, j); const int n = (c.K / 64) * ((c.N + CVT_TN - 1) / CVT_TN); if (rem < n || j == NCVT - 1) break; rem -= n; }
    const int nkt = c.K / 64; k0 = (rem % nkt) * 64; n0 = (rem / nkt) * CVT_TN;
}
DI f32x4 cvt_load(const CvtJob& c, int k0, int n0, int r, int c4) {
    f32x4 v = (f32x4){0.f, 0.f, 0.f, 0.f};
    if (n0 + c4 + 3 < c.N) v = *(const f32x4*)(c.src + (size_t)(k0 + r) * c.ld + n0 + c4);
    else { for (int e = 0; e < 4; ++e) if (n0 + c4 + e < c.N) v[e] = c.src[(size_t)(k0 + r) * c.ld + n0 + c4 + e]; }
    return v;
}
DI void phase_prologue(const Params& p, char* lds) {
    float* tl = (float*)lds;
    const int tid = threadIdx.x, lane = tid & 63;
    const int gtid = blockIdx.x * 512 + tid, gn = gridDim.x * 512, gw = blockIdx.x * 8 + (tid >> 6), nw = gridDim.x * 8;
    {
        constexpr size_t NV4 = (size_t)DB * (WINS - DS) * 128;
        for (size_t i0 = (size_t)gtid * 8; i0 < NV4; i0 += (size_t)gn * 8) {
            f32x4 v[8];
#pragma unroll
            for (int u = 0; u < 8; ++u) { const size_t i = i0 + u; if (i < NV4) { const size_t b = i / ((size_t)(WINS - DS) * 128), r = i % ((size_t)(WINS - DS) * 128); v[u] = *(const f32x4*)(p.state_win + b * WBUF * 512 + (size_t)(WBUF + DS - WINS) * 512 + r * 4); } }
#pragma unroll
            for (int u = 0; u < 8; ++u) { const size_t i = i0 + u; if (i < NV4) { const size_t b = i / ((size_t)(WINS - DS) * 128), r = i % ((size_t)(WINS - DS) * 128); *(f32x4*)(p.win_sample + b * WINS * 512 + r * 4) = v[u]; } }
        }
    }
    int total = 0;
    for (int j = 0; j < NCVT; ++j) { const CvtJob c = cvt_job(p, j); total += (c.K / 64) * ((c.N + CVT_TN - 1) / CVT_TN); }
    {
        const int r0 = tid >> 6, c4 = (tid & 63) * 4;
        for (int t = blockIdx.x; t < total; t += gridDim.x) {
            CvtJob c; int k0, n0; cvt_locate(p, t, c, k0, n0);
            f32x4 v[8];
#pragma unroll
            for (int i = 0; i < 8; ++i) v[i] = cvt_load(c, k0, n0, r0 + 8 * i, c4);
            __syncthreads();
#pragma unroll
            for (int i = 0; i < 8; ++i) { for (int e = 0; e < 4; ++e) tl[(r0 + 8 * i) * 257 + c4 + e] = v[i][e]; }
            __syncthreads();
#pragma unroll
            for (int i = 0; i < 4; ++i) {
                const int cc = tid + 512 * i, nr = cc >> 3, kc = (cc & 7) * 8, n = n0 + nr;
                if (n < c.N) {
                    const float sc = (n >= c.slo && n < c.shi) ? c.scale : 1.f;
                    f32x4 a, b;
                    for (int e = 0; e < 4; ++e) { a[e] = tl[(kc + e) * 257 + nr] * sc; b[e] = tl[(kc + 4 + e) * 257 + nr] * sc; }
                    const int nd = c.ilv ? (n < DFF ? 256 * (n / 128) + n % 128 : 256 * ((n - DFF) / 128) + 128 + (n - DFF) % 128) : n;
                    *(bf16x8*)(c.dst + (size_t)nd * c.K + k0 + kc) = pack8(a, b);
                }
            }
        }
    }
    for (int i = gtid; i < (NNSA_PAD - NNSA) * D / 8; i += gn) *(bf16x8*)(p.Wnsa_in + (size_t)NNSA * D + (size_t)i * 8) = (bf16x8){0, 0, 0, 0, 0, 0, 0, 0};
    for (int i = gtid; i < 2 * 128 * 128; i += gn) { const int c = i >> 14, n = (i >> 7) & 127, k = i & 127; const float* w2 = c ? p.w_cv2 : p.w_ck2; p.Wc2[i] = n < 64 ? f2bf(w2[k * 64 + n]) : (bf16_t)0; }
    for (int i = gtid; i < 256 * D; i += gn) { const int r = i >> 10, k = i & 1023; float v = 0.f; if (r < BATCH) v = siluf(p.c_prompt[r * D + k]); else if (r < NBAT) v = siluf(p.c_sample[(r - BATCH) * D + k]); p.scb[i] = f2bf(v); }
    for (int i = gtid; i < NBAT * NCBS * 256 / 8; i += gn) { ((bf16x8*)p.kc)[i] = (bf16x8){0, 0, 0, 0, 0, 0, 0, 0}; ((bf16x8*)p.vcT)[i] = (bf16x8){0, 0, 0, 0, 0, 0, 0, 0}; }
    for (int i = gw; i < 256; i += nw) { const int c = i >> 7, n = i & 127; const float* pe = c ? p.pe_cv : p.pe_ck; const float* w1 = c ? p.w_cv1 : p.w_ck1; float s = 0.f;
#pragma unroll 8
        for (int k = lane; k < 2048; k += 64) s += pe[k] * w1[(size_t)k * 128 + n];
        s = wave_sum(s); if (lane == 0) p.cbias[i] = s; }
}

template <bool TWO>
DI void phase_normmod(const Params& p, bool from_input, const float* g1, int sh1, int sc1, bf16_t* dst1, const float* g2, int sh2, int sc2, bf16_t* dst2) {
    const int lane = threadIdx.x & 63, gw = blockIdx.x * 8 + (threadIdx.x >> 6), nw = gridDim.x * 8;
    for (int tok = gw; tok < TT; tok += nw) {
        const float* mrow = p.mod + (size_t)tok_batch(tok) * MODN;
        f32x4 v[4]; float ss = 0.f;
#pragma unroll
        for (int i = 0; i < 4; ++i) { v[i] = from_input ? *(const f32x4*)(x_in_row(p, tok) + i * 256 + lane * 4) : unpack4(*(const bf16x4*)(p.X + (size_t)tok * D + i * 256 + lane * 4)); ss += v[i].x * v[i].x + v[i].y * v[i].y + v[i].z * v[i].z + v[i].w * v[i].w; }
        ss = wave_sum(ss);
        const float rstd = 1.0f / sqrtf(ss * (1.0f / D) + 1e-6f);
#pragma unroll
        for (int i = 0; i < 4; ++i) {
            const int c = i * 256 + lane * 4;
            const f32x4 g = *(const f32x4*)(g1 + c), sh = *(const f32x4*)(mrow + sh1 + c), sc = *(const f32x4*)(mrow + sc1 + c);
            f32x4 o; for (int e = 0; e < 4; ++e) o[e] = v[i][e] * rstd * g[e] * (1.f + sc[e]) + sh[e];
            *(bf16x4*)(dst1 + (size_t)tok * D + c) = pack4(o);
            if (TWO) {
                const f32x4 gg = *(const f32x4*)(g2 + c), sh_ = *(const f32x4*)(mrow + sh2 + c), sc_ = *(const f32x4*)(mrow + sc2 + c);
                f32x4 o2; for (int e = 0; e < 4; ++e) o2[e] = v[i][e] * rstd * gg[e] * (1.f + sc_[e]) + sh_[e];
                *(bf16x4*)(dst2 + (size_t)tok * D + c) = pack4(o2);
            }
        }
    }
}
DI void phase_final_norm(const Params& p) {
    const int lane = threadIdx.x & 63, gw = blockIdx.x * 8 + (threadIdx.x >> 6), nw = gridDim.x * 8;
    for (int tok = gw; tok < TT; tok += nw) {
        float* yr = tok < TP ? p.y_prompt + (size_t)tok * D : p.y_sample + (size_t)(tok - TP) * D;
        f32x4 v[4]; float ss = 0.f;
#pragma unroll
        for (int i = 0; i < 4; ++i) { v[i] = unpack4(*(const bf16x4*)(p.X + (size_t)tok * D + i * 256 + lane * 4)); ss += v[i].x * v[i].x + v[i].y * v[i].y + v[i].z * v[i].z + v[i].w * v[i].w; }
        ss = wave_sum(ss);
        const float rstd = 1.0f / sqrtf(ss * (1.0f / D) + 1e-6f);
#pragma unroll
        for (int i = 0; i < 4; ++i) { const int c = i * 256 + lane * 4; const f32x4 g = *(const f32x4*)(p.g_final + c); f32x4 o; for (int e = 0; e < 4; ++e) o[e] = v[i][e] * rstd * g[e]; *(f32x4*)(yr + c) = o; }
    }
}

struct EpiAda {
    static constexpr bool WIDE8 = false;
    float* mod; const float *b_ada, *b_ada_kv;
    DI void operator()(int m, int n, f32x4 v) const {
        if (m >= NBAT) return;
        const float* b = n < 12 * D ? b_ada + n : b_ada_kv + (n - 12 * D);
        const f32x4 bv = *(const f32x4*)b;
        *(f32x4*)(mod + (size_t)m * MODN + n) = v + bv;
    }
};
DI float ret_gamma_log2(int h) {
    return h == 0 ? -0.045803689613124755f : h == 1 ? -0.022720076500083520f : h == 2 ? -0.011315313227834093f : -0.005646563141142062f;
}
#ifdef EMU
DI float exp2_fast(float x) { return exp2f(x); }
#else
DI float exp2_fast(float x) { return __builtin_amdgcn_exp2f(x); }
#endif
struct EpiRetIn {
    static constexpr bool WIDE8 = false;
    bf16_t *qb, *kb, *vb, *sgb, *kT, *vT;
    DI void operator()(int m, int n, f32x4 v) const {
        const int i = m < TP ? (m % SEQ) % CH : (m - TP) % DS;
        if (n < NQ) { const float f = exp2_fast(ret_gamma_log2(n >> 8) * (float)i); *(bf16x4*)(qb + (size_t)m * NQ + n) = pack4(v * f); }
        else if (n < 2 * NQ) {
            const int c = n - NQ, h = c >> 8; const float f = exp2_fast(-ret_gamma_log2(h) * (float)i); const f32x4 kv = v * f;
            *(bf16x4*)(kb + (size_t)m * NQ + c) = pack4(kv);
            if (m < TP) { const int b = m / SEQ, t = m % SEQ; for (int e = 0; e < 4; ++e) kT[((size_t)(b * HA + h) * DK + (c & 255) + e) * SEQ + t] = f2bf(kv[e]); }
        } else if (n < 2 * NQ + NV) {
            const int c = n - 2 * NQ;
            if (m >= TP) *(bf16x4*)(vb + (size_t)m * NV + c) = pack4(v);
            else { const int b = m / SEQ, t = m % SEQ; for (int e = 0; e < 4; ++e) vT[((size_t)b * NV + c + e) * SEQ + t] = f2bf(v[e]); }
        } else { const int c = n - 2 * NQ - NV; f32x4 s; for (int e = 0; e < 4; ++e) s[e] = silu_fast(v[e]); *(bf16x4*)(sgb + (size_t)m * NV + c) = pack4(s); }
    }
};
struct EpiResid {
    static constexpr bool WIDE8 = true;
    const Params* p; bool from_input; int gate_off;
    DI void operator()(int m, int n, f32x4 v) const {
        const f32x4 x = from_input ? *(const f32x4*)(x_in_row(*p, m) + n) : unpack4(*(const bf16x4*)(p->X + (size_t)m * D + n));
        const f32x4 g = *(const f32x4*)(p->mod + (size_t)tok_batch(m) * MODN + gate_off + n);
        *(bf16x4*)(p->X + (size_t)m * D + n) = pack4(x + g * v);
    }
    DI void wide(int m, int n, f32x4 v0, f32x4 v1) const {
        f32x4 x0, x1;
        if (from_input) { const float* xr = x_in_row(*p, m) + n; x0 = *(const f32x4*)xr; x1 = *(const f32x4*)(xr + 4); }
        else { const bf16x8 xb = *(const bf16x8*)(p->X + (size_t)m * D + n); for (int e = 0; e < 4; ++e) { x0[e] = bf2f((bf16_t)xb[e]); x1[e] = bf2f((bf16_t)xb[4 + e]); } }
        const float* gp = p->mod + (size_t)tok_batch(m) * MODN + gate_off + n;
        *(bf16x8*)(p->X + (size_t)m * D + n) = pack8(x0 + *(const f32x4*)gp * v0, x1 + *(const f32x4*)(gp + 4) * v1);
    }
};
struct EpiFfnConv {
    static constexpr bool PERM = true, AFTER_DRAIN = false;
    const Params* p; int l; int M;
    template <bool SAMPLE>
    __device__ __forceinline__ void body(const pg8::f32x4 (&acc)[2][2][4][2], const pg8::Unit& u, int wr, int wc, int fr, int fq) const {
        const Params& P = *p;
        const float* cw = P.conv_w + (size_t)l * 3 * F2; const float* cb = P.conv_b + (size_t)l * F2;
        const bool seq_end = SAMPLE ? true : (((u.pm + 1) * 256) % SEQ == 0);
#pragma unroll
        for (int n = 0; n < 2; ++n) {
            const int ca = u.pn * 128 + wc * 32 + 8 * fq + 4 * n;
            f32x4 w0[2], w1[2], w2[2], bb[2];
#pragma unroll
            for (int bj = 0; bj < 2; ++bj) { const int col = bj * DFF + ca; w0[bj] = *(const f32x4*)(cw + col); w1[bj] = *(const f32x4*)(cw + F2 + col); w2[bj] = *(const f32x4*)(cw + 2 * F2 + col); bb[bj] = *(const f32x4*)(cb + col); }
#pragma unroll
            for (int ai = 0; ai < 2; ++ai)
#pragma unroll
                for (int m = 0; m < 4; ++m) {
                    const int row = u.pm * 256 + ai * 128 + wr * 64 + 16 * m + fr;
                    const int t = SAMPLE ? (row - TP) % DS : 2;
                    const float* hist = (SAMPLE && row < M) ? P.state_conv + ((size_t)l * DB + (row - TP) / DS) * 2 * F2 : nullptr;
                    f32x4 z[2];
#pragma unroll
                    for (int bj = 0; bj < 2; ++bj) {
                        const f32x4 cur = acc[ai][bj][m][n], prv = acc[ai][bj][m > 0 ? m - 1 : 0][n];
                        f32x4 x1, x0;
#pragma unroll
                        for (int e = 0; e < 4; ++e) { x1[e] = dpp_shr<1>(cur[e], dpp_ror<1>(prv[e])); x0[e] = dpp_shr<2>(cur[e], dpp_ror<2>(prv[e])); }
                        if (SAMPLE) {
                            const int col = bj * DFF + ca;
                            if (t < 1) x1 = hist ? *(const f32x4*)(hist + F2 + col) : (f32x4){0.f, 0.f, 0.f, 0.f};
                            if (t < 2) x0 = hist ? *(const f32x4*)(hist + (size_t)t * F2 + col) : (f32x4){0.f, 0.f, 0.f, 0.f};
                        }
                        z[bj] = bb[bj] + w0[bj] * x0 + w1[bj] * x1 + w2[bj] * cur;
                    }
                    if (SAMPLE ? row < M : true) {
                        if (!(m == 0 && fr < 2)) {
                            f32x4 a0;
#pragma unroll
                            for (int e = 0; e < 4; ++e) a0[e] = silu_fast(z[1][e]) * z[0][e];
                            *(bf16x4*)(P.actf + (size_t)row * DFF + ca) = pack4(a0);
                        }
                        if (m == 0 || m == 3) {
                            const int sr = (m == 0 && fr < 2) ? fr : ((m == 3 && fr >= 14) ? fr - 12 : -1);
                            if (sr >= 0) {
#pragma unroll
                                for (int bj = 0; bj < 2; ++bj) *(bf16x4*)(P.uh + ((size_t)(row >> 6) * 4 + sr) * F2 + bj * DFF + ca) = pack4(acc[ai][bj][m][n]);
                            }
                        }
                        if (SAMPLE) {
                            if (t >= DS - 2) { float* cd = P.conv_sample + (size_t)l * DB * 2 * F2 + ((size_t)((row - TP) / DS) * 2 + (t - (DS - 2))) * F2;
#pragma unroll
                                for (int bj = 0; bj < 2; ++bj) *(f32x4*)(cd + bj * DFF + ca) = acc[ai][bj][m][n]; }
                        } else if (ai == 1 && m == 3) {
                            if (seq_end && wr == 1 && fr >= 14) { float* cd = P.conv_prompt + (size_t)l * BATCH * 2 * F2 + ((size_t)(row / SEQ) * 2 + (fr - 14)) * F2;
#pragma unroll
                                for (int bj = 0; bj < 2; ++bj) *(f32x4*)(cd + bj * DFF + ca) = acc[ai][bj][m][n]; }
                        }
                    }
                }
#ifndef EMU
            asm volatile("" ::: "memory");
#endif
        }
    }
    __device__ __forceinline__ void operator()(const pg8::f32x4 (&acc)[2][2][4][2], const pg8::Unit& u, int wr, int wc, int fr, int fq) const {
        if (u.pm * 256 >= TP) body<true>(acc, u, wr, wc, fr, fq); else body<false>(acc, u, wr, wc, fr, fq);
    }
};
DI void conv_fix_segments(const Params& p, int l, int seg0, int nseg) {
    const float* cw = p.conv_w + (size_t)l * 3 * F2; const float* cb = p.conv_b + (size_t)l * F2;
    const int NI = nseg * 2 * (DFF / 8);
    for (int idx = threadIdx.x; idx < NI; idx += 512) {
        const int c = (idx % (DFF / 8)) * 8, rk = idx / (DFF / 8), k = rk & 1, seg = seg0 + (rk >> 1), row = seg * 64 + k;
        const int t = row < TP ? row % SEQ : (row - TP) % DS;
        const float* hist = row < TP ? nullptr : p.state_conv + ((size_t)l * DB + (row - TP) / DS) * 2 * F2;
        float za[8], zg[8];
#pragma unroll
        for (int half = 0; half < 2; ++half) {
            const int col = half * DFF + c; float* z = half ? zg : za;
            const bf16x8 u2 = *(const bf16x8*)(p.uh + ((size_t)seg * 4 + k) * F2 + col);
            float x0[8], x1[8];
            if (t >= 1) { const bf16x8 v = k == 1 ? *(const bf16x8*)(p.uh + ((size_t)seg * 4 + 0) * F2 + col) : *(const bf16x8*)(p.uh + ((size_t)(seg - 1) * 4 + 3) * F2 + col); for (int e = 0; e < 8; ++e) x1[e] = bf2f((bf16_t)v[e]); }
            else { for (int e = 0; e < 8; ++e) x1[e] = hist ? hist[F2 + col + e] : 0.f; }
            if (t >= 2) { const bf16x8 v = k == 1 ? *(const bf16x8*)(p.uh + ((size_t)(seg - 1) * 4 + 3) * F2 + col) : *(const bf16x8*)(p.uh + ((size_t)(seg - 1) * 4 + 2) * F2 + col); for (int e = 0; e < 8; ++e) x0[e] = bf2f((bf16_t)v[e]); }
            else { for (int e = 0; e < 8; ++e) x0[e] = hist ? hist[(size_t)t * F2 + col + e] : 0.f; }
            for (int e = 0; e < 8; ++e) z[e] = cb[col + e] + cw[col + e] * x0[e] + cw[F2 + col + e] * x1[e] + cw[2 * F2 + col + e] * bf2f((bf16_t)u2[e]);
        }
        f32x4 a, b2; for (int e = 0; e < 4; ++e) { a[e] = siluf(zg[e]) * za[e]; b2[e] = siluf(zg[4 + e]) * za[4 + e]; }
        *(bf16x8*)(p.actf + (size_t)row * DFF + c) = pack8(a, b2);
    }
}
struct EpiKv {
    static constexpr bool WIDE8 = false;
    const Params* p;
    DI void operator()(int m, int n, f32x4 v) const {
        const Params& P = *p;
        if (m < TP) {
            const int b = m / SEQ, t = m % SEQ;
            if ((n >= 512 && n < 768) || (n >= 1024 && n < 1280)) *(bf16x4*)(P.kvb + (size_t)m * NKV + n) = pack4(v);
            if (n < 512) *(bf16x4*)(P.Acmp + ((size_t)(n >> 8) * CROWS_PAD + (size_t)(b * NPC_P + (t >> 4)) * 4 + ((n >> 6) & 3)) * 1024 + (t & 15) * 64 + (n & 63)) = pack4(v);
            if (n < 1024) *(f32x4*)(P.kv_prompt + (size_t)m * 1024 + n) = v;
            else if (t >= SEQ - WINP) *(f32x4*)(P.win_prompt + ((size_t)b * WINP + (t - (SEQ - WINP))) * 512 + (n - 1024)) = v;
            if (n >= 768 && n < 1024) { for (int e = 0; e < 4; ++e) P.vTs[((size_t)b * 256 + (n - 768) + e) * SEQ + t] = f2bf(v[e]); }
            if (n >= 1280) { for (int e = 0; e < 4; ++e) P.vTw[((size_t)b * 256 + (n - 1280) + e) * SEQ + t] = f2bf(v[e]); }
        } else {
            const int b = (m - TP) / DS, t = (m - TP) % DS;
            if (n < 1024) *(f32x4*)(P.kv_sample + (size_t)(m - TP) * 1024 + n) = v;
            else *(f32x4*)(P.win_sample + ((size_t)b * WINS + (WINS - DS + t)) * 512 + (n - 1024)) = v;
        }
    }
};
struct EpiNsaIn {
    static constexpr bool WIDE8 = false;
    bf16_t* qb; float* gates;
    DI void operator()(int m, int n, f32x4 v) const {
        if (n < HB * DH) *(bf16x4*)(qb + (size_t)m * (HB * DH) + n) = pack4(v);
        else if (n < NNSA) { f32x4 s; for (int e = 0; e < 4; ++e) s[e] = sigmoid_fast(v[e]); *(f32x4*)(gates + (size_t)m * 48 + (n - HB * DH)) = s; }
    }
};
struct LoadCmp {
    const Params* p; int c;
    DI bf16x8 operator()(int r, int k0) const {
        const Params& P = *p; const int s = k0 >> 6, d0 = k0 & 63;
        if (r < CROWS_P) { const int g = r & 3, j = (r >> 2) % NPC_P, b = (r >> 2) / NPC_P; return *(const bf16x8*)(P.kvb + (size_t)(b * SEQ + 16 * j + s) * NKV + c * 256 + g * 64 + d0); }
        const int rr = r - CROWS_P, g = rr & 3, j = (rr >> 2) % NPC_S, b = (rr >> 2) / NPC_S, pos = 16 * j + s;
        const int page = P.page_table[b * NPAGES + (pos >> 7)];
        const float* src = P.cache_kv + ((size_t)page * PAGE + (pos & 127)) * 1024 + c * 256 + g * 64 + d0;
        return pack8(*(const f32x4*)src, *(const f32x4*)(src + 4));
    }
};
struct EpiZ1 {
    static constexpr bool WIDE8 = true; bf16_t* Z1; DI void operator()(int m, int n, f32x4 v) const { *(bf16x4*)(Z1 + (size_t)m * 256 + n) = pack4(v); }
    DI void wide(int m, int n, f32x4 v0, f32x4 v1) const { *(bf16x8*)(Z1 + (size_t)m * 256 + n) = pack8(v0, v1); } };
struct LoadCmp2 {
    const bf16_t* Z1; const float* bias;
    DI bf16x8 operator()(int r, int k0) const {
        const int npc = r < CROWS_P ? NPC_P : NPC_S; const int i = ((r < CROWS_P ? r : r - CROWS_P) >> 2) % npc;
        const int r2 = (i + 1 < npc) ? r + 4 : r;
        const bf16x8 z0 = *(const bf16x8*)(Z1 + (size_t)r * 256 + k0), z1 = *(const bf16x8*)(Z1 + (size_t)r2 * 256 + 128 + k0);
        const f32x4 c0 = *(const f32x4*)(bias + k0), c1 = *(const f32x4*)(bias + k0 + 4);
        f32x4 a, b;
        for (int e = 0; e < 4; ++e) { a[e] = siluf(bf2f((bf16_t)z0[e]) + bf2f((bf16_t)z1[e]) + c0[e]); b[e] = siluf(bf2f((bf16_t)z0[4 + e]) + bf2f((bf16_t)z1[4 + e]) + c1[e]); }
        return pack8(a, b);
    }
};
struct EpiCmp2 {
    static constexpr bool WIDE8 = false;
    bf16_t* kc; bf16_t* vcT; int c;
    DI void operator()(int m, int n, f32x4 v) const {
        if (n >= 64) return;
        int bb, i, g;
        if (m < CROWS_P) { g = m & 3; i = (m >> 2) % NPC_P; bb = (m >> 2) / NPC_P; if (i >= NCB_P) v = (f32x4){0.f, 0.f, 0.f, 0.f}; }
        else { const int rr = m - CROWS_P; g = rr & 3; i = (rr >> 2) % NPC_S; bb = BATCH + (rr >> 2) / NPC_S; if (i >= NCB_S) v = (f32x4){0.f, 0.f, 0.f, 0.f}; }
        if (c == 0) *(bf16x4*)(kc + ((size_t)(bb * NCBS + i) * 4 + g) * 64 + n) = pack4(v);
        else { for (int e = 0; e < 4; ++e) vcT[((size_t)(bb * 4 + g) * 64 + n + e) * NCBS + i] = f2bf(v[e]); }
    }
};

DI void phase_ret_prompt(const Params& p, char* lds) {
    constexpr int STP = 264, KPP = 264, VTP = 136;
    bf16_t* ST = (bf16_t*)lds;
    bf16_t* Kp = ST + 64 * STP;
    bf16_t* VTs = Kp + 128 * KPP;
    const int tid = threadIdx.x, lane = tid & 63, w = UNIFORM(tid >> 6), l15 = lane & 15, q = lane >> 4;
    for (int item = blockIdx.x; item < BATCH * HA * 8; item += gridDim.x) {
        const int es = item & 7, h = (item >> 3) & 3, b = item >> 5;
        const float lg2 = ret_gamma_log2(h), gam = exp2f(lg2), gam127 = exp2f(lg2 * 127.f);
        f32x4 S[2][4];
#pragma unroll
        for (int i = 0; i < 2; ++i)
#pragma unroll
            for (int j = 0; j < 4; ++j) S[i][j] = (f32x4){0.f, 0.f, 0.f, 0.f};
        __syncthreads();
        for (int i = tid; i < 64 * STP / 8; i += 512) ((bf16x8*)ST)[i] = (bf16x8){0, 0, 0, 0, 0, 0, 0, 0};
        const bf16_t* vTb = p.vT + ((size_t)b * NV + h * DV + es * 64) * SEQ;
        const bf16_t* kTb = p.kT + ((size_t)(b * HA + h) * DK) * SEQ;
        constexpr int NC = SEQ / CH;
        bf16x8 rk[8], rv[2], qf[8], ka[2][4];
        auto load_stage = [&](int cn) { const int t0n = cn * CH; const unsigned tbn = (unsigned)(b * SEQ + t0n);
#pragma unroll
            for (int i = 0; i < 8; ++i) { const int cc = tid + 512 * i; rk[i] = *(const bf16x8*)(p.kb + ((tbn + (unsigned)(cc >> 5)) * NQ + (unsigned)(h * DK + (cc & 31) * 8))); }
#pragma unroll
            for (int i = 0; i < 2; ++i) { const int cc = tid + 512 * i; rv[i] = *(const bf16x8*)(vTb + (unsigned)((cc >> 4) * SEQ + t0n + (cc & 15) * 8)); } };
        auto load_q = [&](int cn) { const unsigned tbn = (unsigned)(b * SEQ + cn * CH);
#pragma unroll
            for (int ks = 0; ks < 8; ++ks) qf[ks] = *(const bf16x8*)(p.qb + ((tbn + (unsigned)(16 * w + l15)) * NQ + (unsigned)(h * DK + ks * 32 + q * 8))); };
        auto load_ka = [&](int cn) { const int t0n = cn * CH;
#pragma unroll
            for (int i = 0; i < 2; ++i)
#pragma unroll
                for (int ks2 = 0; ks2 < 4; ++ks2) ka[i][ks2] = *(const bf16x8*)(kTb + (unsigned)((32 * w + 16 * i + l15) * SEQ + t0n + 32 * ks2 + 8 * q)); };
        load_stage(0); load_q(0); load_ka(0);
#pragma unroll 1
        for (int c = 0; c < NC; ++c) {
            const int t0 = c * CH; const unsigned tokbase = (unsigned)(b * SEQ + t0);
            const int cn = c + 1 < NC ? c + 1 : c;
#pragma unroll
            for (int i = 0; i < 8; ++i) { const int cc = tid + 512 * i; *(bf16x8*)(Kp + (cc >> 5) * KPP + (cc & 31) * 8) = rk[i]; }
#pragma unroll
            for (int i = 0; i < 2; ++i) { const int cc = tid + 512 * i; *(bf16x8*)(VTs + (cc >> 4) * VTP + (cc & 15) * 8) = rv[i]; }
            __syncthreads();
            load_stage(cn);
            f32x4 O[4];
#pragma unroll
            for (int ef = 0; ef < 4; ++ef) O[ef] = (f32x4){0.f, 0.f, 0.f, 0.f};
#pragma unroll
            for (int ks = 0; ks < 8; ++ks)
#pragma unroll
                for (int ef = 0; ef < 4; ++ef) { const bf16x8 a = *(const bf16x8*)(ST + (16 * ef + l15) * STP + ks * 32 + q * 8); O[ef] = MFMA16(a, qf[ks], O[ef]); }
#pragma unroll 1
            for (int jt2 = 0; jt2 <= (w >> 1); ++jt2) {
                f32x4 pt0 = (f32x4){0.f, 0.f, 0.f, 0.f}, pt1 = pt0;
#pragma unroll
                for (int ks = 0; ks < 8; ++ks) {
                    const bf16x8 k0 = *(const bf16x8*)(Kp + (32 * jt2 + l15) * KPP + ks * 32 + q * 8);
                    const bf16x8 k1 = *(const bf16x8*)(Kp + (32 * jt2 + 16 + l15) * KPP + ks * 32 + q * 8);
                    pt0 = MFMA16(k0, qf[ks], pt0); pt1 = MFMA16(k1, qf[ks], pt1);
                }
                const int i = 16 * w + l15, j0 = 32 * jt2 + 4 * q;
#pragma unroll
                for (int r = 0; r < 4; ++r) { if (j0 + r > i) pt0[r] = 0.f; if (j0 + 16 + r > i) pt1[r] = 0.f; }
                const bf16x8 pf = pack8(pt0, pt1);
#pragma unroll
                for (int ef = 0; ef < 4; ++ef) {
                    const bf16_t* vp = VTs + (16 * ef + l15) * VTP + 32 * jt2 + 4 * q;
                    O[ef] = MFMA16(cat4(*(const bf16x4*)vp, *(const bf16x4*)(vp + 16)), pf, O[ef]);
                }
            }
            {
                float ss = 0.f;
#pragma unroll
                for (int ef = 0; ef < 4; ++ef) { *(bf16x4*)(p.obuf + ((tokbase + (unsigned)(16 * w + l15)) * NV + (unsigned)(h * DV + es * 64 + 16 * ef + 4 * q))) = pack4(O[ef]); for (int r = 0; r < 4; ++r) ss += O[ef][r] * O[ef][r]; }
                ss += __shfl_xor(ss, 16); ss += __shfl_xor(ss, 32);
                if (q == 0) p.ssq[(tokbase + (unsigned)(16 * w + l15)) * 32 + h * 8 + es] = ss;
            }
            load_q(cn);
#pragma unroll
            for (int i = 0; i < 2; ++i)
#pragma unroll
                for (int j = 0; j < 4; ++j) S[i][j] = S[i][j] * gam;
#pragma unroll
            for (int ks2 = 0; ks2 < 4; ++ks2) {
#pragma unroll
                for (int j = 0; j < 4; ++j) {
                    const bf16x8 vb_ = *(const bf16x8*)(VTs + (16 * j + l15) * VTP + 32 * ks2 + 8 * q);
#pragma unroll
                    for (int i = 0; i < 2; ++i) S[i][j] = MFMA16(ka[i][ks2], vb_, S[i][j]);
                }
            }
            load_ka(cn);
#pragma unroll
            for (int i = 0; i < 2; ++i)
#pragma unroll
                for (int j = 0; j < 4; ++j) S[i][j] = S[i][j] * gam127;
            __syncthreads();
#pragma unroll
            for (int i = 0; i < 2; ++i)
#pragma unroll
                for (int j = 0; j < 4; ++j) *(bf16x4*)(ST + (16 * j + l15) * STP + 32 * w + 16 * i + 4 * q) = pack4(S[i][j] * gam);
        }
        float* so = p.ret_prompt + ((size_t)(b * HA + h) * DK) * DV + es * 64;
#pragma unroll
        for (int i = 0; i < 2; ++i)
#pragma unroll
            for (int j = 0; j < 4; ++j)
#pragma unroll
                for (int r = 0; r < 4; ++r) so[(size_t)(32 * w + 16 * i + 4 * q + r) * DV + 16 * j + l15] = S[i][j][r];
    }
}
DI void phase_ret_sample(const Params& p, char* lds) {
    float* Lq = (float*)lds; float* Lk = Lq + 2048; float* LP = Lk + 2048; float* Lo = LP + 64;
    const int tid = threadIdx.x, lane = tid & 63, w = tid >> 6;
    for (int item = blockIdx.x; item < DB * HA; item += gridDim.x) {
        const int b = item >> 2, h = item & 3; const size_t tok0 = (size_t)TP + b * DS;
        const float lg2 = ret_gamma_log2(h), gam = exp2f(lg2), g7 = exp2f(lg2 * 7.f), g8 = exp2f(lg2 * 8.f);
        __syncthreads();
        for (int i = tid; i < 2048; i += 512) { const int t = i >> 8, d = i & 255; Lq[i] = bf2f(p.qb[(tok0 + t) * NQ + h * DK + d]); Lk[i] = bf2f(p.kb[(tok0 + t) * NQ + h * DK + d]); }
        __syncthreads();
        if (tid < 64) { const int i = tid >> 3, j = tid & 7; float s = 0.f; if (j <= i) for (int d = 0; d < DK; ++d) s += Lq[i * 256 + d] * Lk[j * 256 + d]; LP[tid] = s; }
        const int dq = tid >> 7, e0 = (tid & 127) * 4;
        f32x4 vv[8], oacc[8];
#pragma unroll
        for (int j = 0; j < 8; ++j) { const bf16x4 t = *(const bf16x4*)(p.vb + (tok0 + j) * NV + h * DV + e0); for (int e = 0; e < 4; ++e) vv[j][e] = bf2f((bf16_t)t[e]); oacc[j] = (f32x4){0.f, 0.f, 0.f, 0.f}; }
        const float* S0 = p.state_ret + ((size_t)(b * HA + h) * DK) * DV; float* S1 = p.ret_sample + ((size_t)(b * HA + h) * DK) * DV;
        {
            f32x4 sv[2][4];
#pragma unroll
            for (int u = 0; u < 4; ++u) sv[0][u] = *(const f32x4*)(S0 + (size_t)(dq + 4 * u) * DV + e0);
#pragma unroll 1
            for (int dd = 0; dd < 64; dd += 8) {
#pragma unroll
                for (int half = 0; half < 2; ++half) {
                    const int dn = dd + 4 * half + 4;
                    if (dn < 64) {
#pragma unroll
                        for (int u = 0; u < 4; ++u) sv[half ^ 1][u] = *(const f32x4*)(S0 + (size_t)(dq + 4 * (dn + u)) * DV + e0);
                    }
#pragma unroll
                    for (int u = 0; u < 4; ++u) {
                        const int d = dq + 4 * (dd + 4 * half + u);
                        f32x4 upd = (f32x4){0.f, 0.f, 0.f, 0.f};
#pragma unroll
                        for (int j = 0; j < 8; ++j) { upd += vv[j] * Lk[j * 256 + d]; oacc[j] += sv[half][u] * Lq[j * 256 + d]; }
                        *(f32x4*)(S1 + (size_t)d * DV + e0) = sv[half][u] * g8 + upd * g7;
                    }
                }
            }
        }
#pragma unroll
        for (int i = 0; i < 8; ++i) *(f32x4*)(Lo + (dq * 8 + i) * 512 + e0) = oacc[i];
        __syncthreads();
        {
            const int i = w, e8 = lane * 8; float o[8]; float ss = 0.f;
#pragma unroll
            for (int e = 0; e < 8; ++e) o[e] = gam * (Lo[(0 * 8 + i) * 512 + e8 + e] + Lo[(1 * 8 + i) * 512 + e8 + e] + Lo[(2 * 8 + i) * 512 + e8 + e] + Lo[(3 * 8 + i) * 512 + e8 + e]);
            for (int j = 0; j <= i; ++j) { const float pj = LP[i * 8 + j]; const bf16x8 t = *(const bf16x8*)(p.vb + (tok0 + j) * NV + h * DV + e8); for (int e = 0; e < 8; ++e) o[e] += pj * bf2f((bf16_t)t[e]); }
            f32x4 a, c; for (int e = 0; e < 4; ++e) { a[e] = o[e]; c[e] = o[4 + e]; ss += o[e] * o[e] + o[4 + e] * o[4 + e]; }
            *(bf16x8*)(p.obuf + (tok0 + i) * NV + h * DV + e8) = pack8(a, c);
            ss = wave_sum(ss);
            if (lane < 8) p.ssq[(tok0 + i) * 32 + h * 8 + lane] = lane == 0 ? ss : 0.f;
        }
    }
}
DI void phase_ret_act(const Params& p) {
    const int gtid = blockIdx.x * 512 + threadIdx.x, gn = gridDim.x * 512;
    constexpr int NI = TT * (NV / 8);
    for (int i0 = gtid; i0 < NI; i0 += 4 * gn) {
        bf16x8 o[4], g[4]; float s[4];
#pragma unroll
        for (int u = 0; u < 4; ++u) { const int idx = i0 + u * gn; if (idx < NI) { const int tok = idx / (NV / 8), c8 = (idx % (NV / 8)) * 8, h = c8 / DV;
            o[u] = *(const bf16x8*)(p.obuf + (size_t)tok * NV + c8); g[u] = *(const bf16x8*)(p.sgb + (size_t)tok * NV + c8);
            const f32x4 s0 = *(const f32x4*)(p.ssq + (size_t)tok * 32 + h * 8), s1 = *(const f32x4*)(p.ssq + (size_t)tok * 32 + h * 8 + 4); s[u] = s0.x + s0.y + s0.z + s0.w + s1.x + s1.y + s1.z + s1.w; } }
#pragma unroll
        for (int u = 0; u < 4; ++u) { const int idx = i0 + u * gn; if (idx < NI) { const int tok = idx / (NV / 8), c8 = (idx % (NV / 8)) * 8;
            const float rstd = 1.0f / sqrtf(s[u] * (1.0f / DV) + 1e-6f);
            f32x4 a, c; for (int e = 0; e < 4; ++e) { a[e] = bf2f((bf16_t)o[u][e]) * rstd * bf2f((bf16_t)g[u][e]); c[e] = bf2f((bf16_t)o[u][4 + e]) * rstd * bf2f((bf16_t)g[u][4 + e]); }
            *(bf16x8*)(p.actr + (size_t)tok * NV + c8) = pack8(a, c); } }
    }
}
DI void phase_conv_act(const Params& p, int l) {
    const int gtid = blockIdx.x * 512 + threadIdx.x, gn = gridDim.x * 512;
    const float* cw = p.conv_w + (size_t)l * 3 * F2; const float* cb = p.conv_b + (size_t)l * F2;
    constexpr int NI = TT * (DFF / 8);
    for (int i0 = gtid; i0 < NI; i0 += 2 * gn) {
        bf16x8 ub[2][2][3];
#pragma unroll
        for (int u = 0; u < 2; ++u) { const int idx = i0 + u * gn; if (idx < NI) { const int tok = idx / (DFF / 8), c = (idx % (DFF / 8)) * 8; const int t = tok < TP ? tok % SEQ : (tok - TP) % DS;
#pragma unroll
            for (int half = 0; half < 2; ++half) { const int col = half * DFF + c;
                ub[u][half][2] = *(const bf16x8*)(p.u + (size_t)tok * F2 + col);
                ub[u][half][1] = *(const bf16x8*)(p.u + (size_t)(t >= 1 ? tok - 1 : tok) * F2 + col);
                ub[u][half][0] = *(const bf16x8*)(p.u + (size_t)(t >= 2 ? tok - 2 : tok) * F2 + col); } } }
#pragma unroll
        for (int u = 0; u < 2; ++u) { const int idx = i0 + u * gn; if (idx < NI) { const int tok = idx / (DFF / 8), c = (idx % (DFF / 8)) * 8; const int t = tok < TP ? tok % SEQ : (tok - TP) % DS;
            const float* hist = tok < TP ? nullptr : p.state_conv + ((size_t)l * DB + (tok - TP) / DS) * 2 * F2;
            float za[8], zg[8];
#pragma unroll
            for (int half = 0; half < 2; ++half) {
                const int col = half * DFF + c; float* z = half ? zg : za;
                float x0[8], x1[8];
                if (t >= 1) { for (int e = 0; e < 8; ++e) x1[e] = bf2f((bf16_t)ub[u][half][1][e]); } else { for (int e = 0; e < 8; ++e) x1[e] = hist ? hist[F2 + col + e] : 0.f; }
                if (t >= 2) { for (int e = 0; e < 8; ++e) x0[e] = bf2f((bf16_t)ub[u][half][0][e]); } else { for (int e = 0; e < 8; ++e) x0[e] = hist ? hist[(size_t)t * F2 + col + e] : 0.f; }
                for (int e = 0; e < 8; ++e) z[e] = cb[col + e] + cw[col + e] * x0[e] + cw[F2 + col + e] * x1[e] + cw[2 * F2 + col + e] * bf2f((bf16_t)ub[u][half][2][e]);
            }
            f32x4 a, b2; for (int e = 0; e < 4; ++e) { a[e] = siluf(zg[e]) * za[e]; b2[e] = siluf(zg[4 + e]) * za[4 + e]; }
            *(bf16x8*)(p.actf + (size_t)tok * DFF + c) = pack8(a, b2); } }
    }
}

constexpr float NEG = -1.0e30f;
DI float alibi_slope(int head) { return LOG2E * exp2f(-0.5f * (float)(head + 1)); }
constexpr int AKP = 72;
DI f32x4 cmp_tile_lds(const bf16_t* Kc, int kt, int t, int lane, bf16x8 q0, bf16x8 q1, float slope_h) {
    const int l15 = lane & 15, q = lane >> 4;
    const bf16_t* kp = Kc + (16 * kt + l15) * AKP + q * 8;
    f32x4 acc = (f32x4){0.f, 0.f, 0.f, 0.f};
    acc = MFMA16(*(const bf16x8*)kp, q0, acc); acc = MFMA16(*(const bf16x8*)(kp + 32), q1, acc);
#pragma unroll
    for (int r = 0; r < 4; ++r) { const int n = 16 * kt + 4 * q + r, cend = 16 * n + 31; acc[r] = (n < NCB_P && cend <= t) ? acc[r] - slope_h * (float)(t - cend) : NEG; }
    return acc;
}
template <int MODE>
DI void attn_tile2(bool FULL, const bf16_t* Kt, const bf16_t* Vt, int jblk, int t, int lane, const bf16x8 (&qf)[2][2], const float (&slope)[2], unsigned selmask,
                   float (&m)[2], float (&l)[2], f32x4 (&O)[2][4]) {
    const int l15 = lane & 15, q = lane >> 4;
    const bool tok_ok = MODE == 0 ? (((selmask >> jblk) & 1u) != 0u) : true;
    {
        constexpr int hp = 0;
        f32x4 sT[2][4];
#pragma unroll
        for (int kt = 0; kt < 4; ++kt) {
            const bf16_t* kp = Kt + (16 * kt + l15) * AKP + q * 8;
            const bf16x8 k0 = *(const bf16x8*)kp, k1 = *(const bf16x8*)(kp + 32);
#pragma unroll
            for (int hh = 0; hh < 2; ++hh) { f32x4 acc = (f32x4){0.f, 0.f, 0.f, 0.f}; acc = MFMA16(k0, qf[2 * hp + hh][0], acc); acc = MFMA16(k1, qf[2 * hp + hh][1], acc); sT[hh][kt] = acc; }
        }
#pragma unroll
        for (int hh = 0; hh < 2; ++hh) {
            const int h4 = 2 * hp + hh;
            float mx = NEG;
            {
                const int tdiff = t - 64 * jblk - 4 * q;
                const float base = -slope[h4] * (float)tdiff;
#pragma unroll
                for (int kt = 0; kt < 4; ++kt)
#pragma unroll
                    for (int r = 0; r < 4; ++r) {
                        float sv = (sT[hh][kt][r] + base) + slope[h4] * (float)(16 * kt + r);
                        if (!FULL) { const bool valid = tok_ok && (16 * kt + r) <= tdiff && (MODE == 0 || tdiff - (16 * kt + r) <= WINDOW); sv = valid ? sv : NEG; }
                        sT[hh][kt][r] = sv; mx = fmaxf(mx, sv);
                    }
            }
            mx = fmaxf(mx, __shfl_xor(mx, 16)); mx = fmaxf(mx, __shfl_xor(mx, 32));
            const float mnew = fmaxf(m[h4], mx), alpha = exp2_fast(m[h4] - mnew);
            float psum = 0.f;
            if (FULL) {
#pragma unroll
                for (int kt = 0; kt < 4; ++kt)
#pragma unroll
                    for (int r = 0; r < 4; ++r) { const float pe = exp2_fast(sT[hh][kt][r] - mnew); sT[hh][kt][r] = pe; psum += pe; }
            } else {
#pragma unroll
                for (int kt = 0; kt < 4; ++kt)
#pragma unroll
                    for (int r = 0; r < 4; ++r) { const float pe = sT[hh][kt][r] > 0.5f * NEG ? exp2_fast(sT[hh][kt][r] - mnew) : 0.f; sT[hh][kt][r] = pe; psum += pe; }
            }
            l[h4] = l[h4] * alpha + psum; m[h4] = mnew;
#pragma unroll
            for (int df = 0; df < 4; ++df) O[h4][df] = O[h4][df] * alpha;
        }
#pragma unroll
        for (int ks2 = 0; ks2 < 2; ++ks2) {
            const bf16x8 pf0 = pack8(sT[0][2 * ks2], sT[0][2 * ks2 + 1]), pf1 = pack8(sT[1][2 * ks2], sT[1][2 * ks2 + 1]);
#pragma unroll
            for (int df = 0; df < 4; ++df) {
                const bf16_t* vp = Vt + (16 * df + l15) * AKP + 32 * ks2 + 4 * q;
                const bf16x8 vf = cat4(*(const bf16x4*)vp, *(const bf16x4*)(vp + 16));
                O[2 * hp][df] = MFMA16(vf, pf0, O[2 * hp][df]); O[2 * hp + 1][df] = MFMA16(vf, pf1, O[2 * hp + 1][df]);
            }
        }
    }
}
template <int MODE>
DI void attn_run_blocks(const Params& p, int b, int g, unsigned list, unsigned wave_need, unsigned wave_full, int t, int lane, int tid, const bf16x8 (&qf)[2][2], const float (&slope)[2], unsigned selmask,
                        float (&m)[2], float (&l)[2], f32x4 (&O)[2][4], bf16_t* Kt, bf16_t* Vt) {
    if (list == 0u) return;
    const bf16_t* kg = p.kvb + (size_t)b * SEQ * NKV + (MODE == 0 ? 512 : 1024) + g * 64 + (unsigned)((tid >> 3) * NKV + (tid & 7) * 8);
    const bf16_t* vg = (MODE == 0 ? p.vTs : p.vTw) + ((size_t)b * 256 + g * 64) * SEQ + (unsigned)((tid >> 3) * SEQ + (tid & 7) * 8);
    const int so = (tid >> 3) * AKP + (tid & 7) * 8;
    unsigned rem = list; int jb = __builtin_ctz(rem); rem &= rem - 1u;
    bf16x8 rk = *(const bf16x8*)(kg + (unsigned)(64 * jb * NKV)), rv = *(const bf16x8*)(vg + 64 * jb);
    int buf = 0;
    __syncthreads();
    *(bf16x8*)(Kt + so) = rk; *(bf16x8*)(Vt + so) = rv;
    __syncthreads();
    for (;;) {
        const int jn = rem ? __builtin_ctz(rem) : -1;
        if (jn >= 0) { rk = *(const bf16x8*)(kg + (unsigned)(64 * jn * NKV)); rv = *(const bf16x8*)(vg + 64 * jn); }
        if ((wave_need >> jb) & 1u) {
            attn_tile2<MODE>(((wave_full >> jb) & 1u) != 0u, Kt + buf * 64 * AKP, Vt + buf * 64 * AKP, jb, t, lane, qf, slope, selmask, m, l, O);
        }
        if (jn < 0) break;
        buf ^= 1;
        *(bf16x8*)(Kt + buf * 64 * AKP + so) = rk; *(bf16x8*)(Vt + buf * 64 * AKP + so) = rv;
        __syncthreads();
        jb = jn; rem &= rem - 1u;
    }
}
DI void phase_attn_prompt2(const Params& p, char* lds) {
    const int tid = threadIdx.x, lane0 = tid & 63, w = UNIFORM(tid >> 6);
    bf16_t* Kc = (bf16_t*)lds;
    bf16_t* VcT = Kc + 128 * AKP;
    unsigned* Lmask = (unsigned*)(VcT + 64 * 136);
    char* dyn = (char*)(Lmask + 16);
    bf16_t* Kt = (bf16_t*)dyn;
    bf16_t* Vt = Kt + 2 * 64 * AKP;
    float* pkey = (float*)dyn + (size_t)w * (16 * 128 + 16 * 32);
    float* impL = pkey + 16 * 128;
    constexpr int NT = SEQ / 128, NBG = BATCH * GB, NIT = NBG * NT;
    for (int it = blockIdx.x; it < NIT; it += gridDim.x) {
        const int r = it / NBG, bg = it % NBG, tile = r < NT / 2 ? NT - 1 - r : r - NT / 2;
        const int b = bg / GB, g = bg % GB, T0 = tile * 128;
        int lane = lane0; OPAQUE(lane);
        const int l15 = lane & 15, q = lane >> 4;
        const int t0 = T0 + 16 * w, t = t0 + l15; const unsigned tok = (unsigned)(b * SEQ + t);
        const float* gt = p.gates + (tok * 48u + (unsigned)(g * 12));
        __syncthreads();
        {
            const int n = tid >> 2, c = (tid & 3) * 16;
            const bf16_t* src = p.kc + ((size_t)(b * NCBS + n) * 4 + g) * 64 + c;
            *(bf16x8*)(Kc + n * AKP + c) = *(const bf16x8*)src; *(bf16x8*)(Kc + n * AKP + c + 8) = *(const bf16x8*)(src + 8);
            const int d = tid >> 3, c2 = (tid & 7) * 16;
            const bf16_t* src2 = p.vcT + ((size_t)(b * 4 + g) * 64 + d) * NCBS + c2;
            *(bf16x8*)(VcT + d * 136 + c2) = *(const bf16x8*)src2; *(bf16x8*)(VcT + d * 136 + c2 + 8) = *(const bf16x8*)(src2 + 8);
        }
        __syncthreads();
        int ncv = (t0 + 15 >= 31) ? (t0 + 15 - 31) / 16 + 1 : 0; ncv = ncv < NCB_P ? ncv : NCB_P;
        const int nkt = (ncv + 15) >> 4;
        bf16x8 qf[4][2]; float slope[4];
#pragma unroll
        for (int hh = 0; hh < 4; ++hh) { slope[hh] = alibi_slope(g * 4 + hh); for (int ks = 0; ks < 2; ++ks) qf[hh][ks] = *(const bf16x8*)(p.qb + (tok * 1024u + (unsigned)((g * 4 + hh) * 64 + ks * 32 + q * 8))); }
        float mC[4], ilC[4];
#pragma unroll
        for (int kt = 0; kt < 8; ++kt) *(f32x4*)(pkey + l15 * 128 + 16 * kt + 4 * q) = (f32x4){0.f, 0.f, 0.f, 0.f};
#pragma unroll
        for (int hh = 0; hh < 4; ++hh) {
            float mx = NEG, sm = 0.f;
#pragma unroll 1
            for (int kt = 0; kt < nkt; ++kt) {
                const f32x4 sv = cmp_tile_lds(Kc, kt, t, lane, qf[hh][0], qf[hh][1], slope[hh]);
                const float tm = fmaxf(fmaxf(sv[0], sv[1]), fmaxf(sv[2], sv[3])), mn = fmaxf(mx, tm);
                float e = 0.f;
#pragma unroll
                for (int rr = 0; rr < 4; ++rr) e += sv[rr] > 0.5f * NEG ? exp2_fast(sv[rr] - mn) : 0.f;
                sm = sm * exp2_fast(mx - mn) + e; mx = mn;
            }
            float ma = fmaxf(mx, __shfl_xor(mx, 16)); ma = fmaxf(ma, __shfl_xor(ma, 32));
            sm *= exp2_fast(mx - ma); sm += __shfl_xor(sm, 16); sm += __shfl_xor(sm, 32);
            mC[hh] = ma; ilC[hh] = 1.0f / fmaxf(sm, 1e-30f);
#pragma unroll 1
            for (int kt = 0; kt < nkt; ++kt) {
                const f32x4 sv = cmp_tile_lds(Kc, kt, t, lane, qf[hh][0], qf[hh][1], slope[hh]);
                f32x4 pv;
#pragma unroll
                for (int rr = 0; rr < 4; ++rr) pv[rr] = sv[rr] > 0.5f * NEG ? exp2_fast(sv[rr] - ma) * ilC[hh] : 0.f;
                float* pk = pkey + l15 * 128 + 16 * kt + 4 * q;
                *(f32x4*)pk = *(const f32x4*)pk + pv;
            }
        }
        WAVE_SYNC();
        const int cur = t >> 6;
        float sc8[8];
#pragma unroll
        for (int f = 0; f < 8; ++f) {
            const int j = 4 * f + q; float imp = 0.f;
#pragma unroll
            for (int dn = -1; dn <= 3; ++dn) { const int n = 4 * j + dn; if (n >= 0 && n < 128) imp += pkey[l15 * 128 + n]; }
            const bool forced = (j == 0) || (j == cur) || (j == cur - 1);
            sc8[f] = j <= cur ? imp + (forced ? 1.0e4f : 0.f) : NEG;
            impL[l15 * 32 + j] = sc8[f];
        }
        WAVE_SYNC();
        unsigned selmask = 0u;
#pragma unroll
        for (int f = 0; f < 8; ++f) {
            const int j = 4 * f + q; const float sv = sc8[f]; int rank = 0;
            for (int jj = 0; jj < 32; ++jj) { const float sj = impL[l15 * 32 + jj]; rank += (sj > sv || (sj == sv && jj < j)) ? 1 : 0; }
            if (j <= cur && rank < NSEL) selmask |= 1u << j;
        }
        selmask |= __shfl_xor(selmask, 16); selmask |= __shfl_xor(selmask, 32);
        unsigned wsel = selmask; wsel |= __shfl_xor(wsel, 1); wsel |= __shfl_xor(wsel, 2); wsel |= __shfl_xor(wsel, 4); wsel |= __shfl_xor(wsel, 8);
        wsel = (unsigned)UNIFORM((int)wsel);
        unsigned wfull = selmask; wfull &= __shfl_xor(wfull, 1); wfull &= __shfl_xor(wfull, 2); wfull &= __shfl_xor(wfull, 4); wfull &= __shfl_xor(wfull, 8);
        wfull = (unsigned)UNIFORM((int)wfull) & ((1u << (t0 >> 6)) - 1u);
        if (lane == 0) Lmask[w] = wsel;
#pragma unroll
        for (int hh = 0; hh < 4; ++hh) {
            f32x4 Oc[4];
#pragma unroll
            for (int df = 0; df < 4; ++df) Oc[df] = (f32x4){0.f, 0.f, 0.f, 0.f};
#pragma unroll 1
            for (int k2 = 0; 2 * k2 < nkt; ++k2) {
                f32x4 s0 = cmp_tile_lds(Kc, 2 * k2, t, lane, qf[hh][0], qf[hh][1], slope[hh]), s1 = cmp_tile_lds(Kc, 2 * k2 + 1, t, lane, qf[hh][0], qf[hh][1], slope[hh]);
#pragma unroll
                for (int rr = 0; rr < 4; ++rr) { s0[rr] = s0[rr] > 0.5f * NEG ? exp2_fast(s0[rr] - mC[hh]) * ilC[hh] : 0.f; s1[rr] = s1[rr] > 0.5f * NEG ? exp2_fast(s1[rr] - mC[hh]) * ilC[hh] : 0.f; }
                const bf16x8 pf = pack8(s0, s1);
#pragma unroll
                for (int df = 0; df < 4; ++df) { const bf16_t* vp = VcT + (16 * df + l15) * 136 + 32 * k2 + 4 * q; Oc[df] = MFMA16(cat4(*(const bf16x4*)vp, *(const bf16x4*)(vp + 16)), pf, Oc[df]); }
            }
            const float gate = gt[hh * 3];
#pragma unroll
            for (int df = 0; df < 4; ++df) *(f32x4*)(p.aof + (tok * 1024u + (unsigned)((g * 4 + hh) * 64 + 16 * df + 4 * q))) = Oc[df] * gate;
        }
        __syncthreads();
        unsigned U = 0u;
        for (int i = 0; i < 8; ++i) U |= Lmask[i];
        U = (unsigned)UNIFORM((int)U);
#pragma unroll 1
        for (int hp = 0; hp < 2; ++hp) {
            bf16x8 q2[2][2]; float sl2[2];
#pragma unroll
            for (int hh = 0; hh < 2; ++hh) { const int head = g * 4 + 2 * hp + hh; sl2[hh] = alibi_slope(head); for (int ks = 0; ks < 2; ++ks) q2[hh][ks] = *(const bf16x8*)(p.qb + (tok * 1024u + (unsigned)(head * 64 + ks * 32 + q * 8))); }
            float m[2], l[2]; f32x4 O[2][4];
#pragma unroll 1
            for (int br = 0; br < 2; ++br) {
#pragma unroll
                for (int hh = 0; hh < 2; ++hh) { m[hh] = NEG; l[hh] = 0.f; for (int df = 0; df < 4; ++df) O[hh][df] = (f32x4){0.f, 0.f, 0.f, 0.f}; }
                if (br == 0) attn_run_blocks<0>(p, b, g, U, wsel, wfull, t, lane, tid, q2, sl2, selmask, m, l, O, Kt, Vt);
                else {
                    const int jlo_b = (T0 - WINDOW) > 0 ? (T0 - WINDOW) >> 6 : 0, jhi_b = (T0 + 127) >> 6;
                    const int jlo_w = (t0 - WINDOW) > 0 ? (t0 - WINDOW) >> 6 : 0, jhi_w = (t0 + 15) >> 6;
                    const unsigned lb = (jhi_b >= 31 ? 0xffffffffu : ((1u << (jhi_b + 1)) - 1u)) & ~((1u << jlo_b) - 1u);
                    const unsigned lw = (jhi_w >= 31 ? 0xffffffffu : ((1u << (jhi_w + 1)) - 1u)) & ~((1u << jlo_w) - 1u);
                    unsigned lf = 0u; for (int jb = jlo_w; jb <= jhi_w; ++jb) if (64 * jb >= t0 + 15 - WINDOW && 64 * jb + 63 <= t0) lf |= 1u << jb;
                    attn_run_blocks<1>(p, b, g, lb, lw, lf, t, lane, tid, q2, sl2, selmask, m, l, O, Kt, Vt);
                }
#pragma unroll
                for (int hh = 0; hh < 2; ++hh) {
                    float lt = l[hh]; lt += __shfl_xor(lt, 16); lt += __shfl_xor(lt, 32);
                    const float sc = gt[(2 * hp + hh) * 3 + 1 + br] / fmaxf(lt, 1e-30f);
#pragma unroll
                    for (int df = 0; df < 4; ++df) {
                        const unsigned off = tok * 1024u + (unsigned)((g * 4 + 2 * hp + hh) * 64 + 16 * df + 4 * q);
                        const f32x4 v = *(const f32x4*)(p.aof + off) + O[hh][df] * sc;
                        if (br == 0) *(f32x4*)(p.aof + off) = v; else *(bf16x4*)(p.ao + off) = pack4(v);
                    }
                }
            }
        }
    }
}

template <int MODE>
DI void attn_sample_unit(const Params& p, int b, int g, int blk, int lane, const bf16x8 (&qf)[2][2], const float (&slope)[2], const unsigned long long* Lsel, bf16_t* Lvt,
                         float (&m)[2], float (&l)[2], f32x4 (&O)[2][4]) {
    const int l15 = lane & 15, q = lane >> 4;
    auto rowptr = [&](int kk, bool isv) -> const float* {
        if (MODE == 0) { int pos = 64 * blk + kk; pos = pos < PAST + DS ? pos : PAST + DS - 1;
            const int pc = pos < PAST ? pos : PAST - 1;
            const float* pa = p.cache_kv + ((size_t)p.page_table[b * NPAGES + (pc >> 7)] * PAGE + (pc & 127)) * 1024;
            const float* pb = p.kv_sample + ((size_t)(b * DS + (pos < PAST ? 0 : pos - PAST))) * 1024;
            return (pos < PAST ? pa : pb) + (isv ? 768 : 512) + g * 64; }
        int idx = 64 * blk + kk; idx = idx < WBUF + DS ? idx : WBUF + DS - 1;
        const float* pa = p.state_win + ((size_t)b * WBUF + (idx < WBUF ? idx : WBUF - 1)) * 512;
        const float* pb = p.win_sample + ((size_t)b * WINS + WINS - DS + (idx < WBUF ? 0 : idx - WBUF)) * 512;
        return (idx < WBUF ? pa : pb) + (isv ? 256 : 0) + g * 64; };
    bf16x8 kf[4][2];
#pragma unroll
    for (int kt = 0; kt < 4; ++kt) { const float* rp = rowptr(16 * kt + l15, false);
#pragma unroll
        for (int ks = 0; ks < 2; ++ks) kf[kt][ks] = pack8(*(const f32x4*)(rp + ks * 32 + q * 8), *(const f32x4*)(rp + ks * 32 + q * 8 + 4)); }
    f32x4 vraw[8];
#pragma unroll
    for (int it = 0; it < 8; ++it) vraw[it] = *(const f32x4*)(rowptr(it * 4 + q, true) + l15 * 4);
    WAVE_SYNC();
#pragma unroll
    for (int it = 0; it < 8; ++it) { const int kk = it * 4 + q; for (int e = 0; e < 4; ++e) Lvt[(l15 * 4 + e) * 72 + kk] = f2bf(vraw[it][e]); }
#pragma unroll
    for (int it = 0; it < 8; ++it) vraw[it] = *(const f32x4*)(rowptr((it + 8) * 4 + q, true) + l15 * 4);
#pragma unroll
    for (int it = 0; it < 8; ++it) { const int kk = (it + 8) * 4 + q; for (int e = 0; e < 4; ++e) Lvt[(l15 * 4 + e) * 72 + kk] = f2bf(vraw[it][e]); }
    WAVE_SYNC();
    const int i = l15 & 7, tpos = PAST + i;
    const bool tok_ok = MODE == 0 ? (((Lsel[i] >> blk) & 1ull) != 0ull) : true;
    const int kbase = MODE == 0 ? 64 * blk : PAST - WBUF + 64 * blk;
#pragma unroll
    for (int rf = 0; rf < 2; ++rf) {
        f32x4 sT[4];
#pragma unroll
        for (int kt = 0; kt < 4; ++kt) { f32x4 acc = (f32x4){0.f, 0.f, 0.f, 0.f}; acc = MFMA16(kf[kt][0], qf[rf][0], acc); acc = MFMA16(kf[kt][1], qf[rf][1], acc); sT[kt] = acc; }
        float mx = NEG;
#pragma unroll
        for (int kt = 0; kt < 4; ++kt)
#pragma unroll
            for (int r = 0; r < 4; ++r) {
                const int kk = 16 * kt + 4 * q + r, dist = tpos - (kbase + kk);
                const bool valid = tok_ok && dist >= 0 && (MODE == 0 || (dist <= WINDOW && 64 * blk + kk < WBUF + DS));
                const float sv = valid ? sT[kt][r] - slope[rf] * (float)dist : NEG; sT[kt][r] = sv; mx = fmaxf(mx, sv);
            }
        mx = fmaxf(mx, __shfl_xor(mx, 16)); mx = fmaxf(mx, __shfl_xor(mx, 32));
        const float mnew = fmaxf(m[rf], mx), alpha = exp2_fast(m[rf] - mnew);
        float psum = 0.f;
#pragma unroll
        for (int kt = 0; kt < 4; ++kt)
#pragma unroll
            for (int r = 0; r < 4; ++r) { const float pe = sT[kt][r] > 0.5f * NEG ? exp2_fast(sT[kt][r] - mnew) : 0.f; sT[kt][r] = pe; psum += pe; }
        l[rf] = l[rf] * alpha + psum; m[rf] = mnew;
#pragma unroll
        for (int df = 0; df < 4; ++df) O[rf][df] = O[rf][df] * alpha;
#pragma unroll
        for (int ks2 = 0; ks2 < 2; ++ks2) { const bf16x8 pf = pack8(sT[2 * ks2], sT[2 * ks2 + 1]);
#pragma unroll
            for (int df = 0; df < 4; ++df) { const bf16_t* vp = Lvt + (16 * df + l15) * 72 + 32 * ks2 + 4 * q; O[rf][df] = MFMA16(cat4(*(const bf16x4*)vp, *(const bf16x4*)(vp + 16)), pf, O[rf][df]); } }
    }
}
DI void phase_attn_sample(const Params& p, char* lds) {
    const int tid = threadIdx.x, lane = tid & 63, w = tid >> 6, l15 = lane & 15, q = lane >> 4;
    float* Lsc = (float*)lds;
    float* Lpt = Lsc + 32 * 128;
    float* Lscore = Lpt + 8 * 128;
    unsigned long long* Lsel = (unsigned long long*)(Lscore + 8 * 64);
    float* Locmp = (float*)(Lsel + 16);
    bf16_t* Lvt_all = (bf16_t*)(Locmp + 32 * 64);
    float* Lcomb = (float*)Lvt_all;
    constexpr int NWB = (WBUF + DS + 63) / 64;
    for (int item = blockIdx.x; item < DB * GB; item += gridDim.x) {
        const int b = item >> 2, g = item & 3, bb = BATCH + b;
        __syncthreads();
        bf16x8 qf[2][2]; float slope[2];
#pragma unroll
        for (int rf = 0; rf < 2; ++rf) { const int head = 2 * rf + (l15 >> 3), i = l15 & 7; slope[rf] = alibi_slope(g * 4 + head);
            for (int ks = 0; ks < 2; ++ks) qf[rf][ks] = *(const bf16x8*)(p.qb + ((size_t)TP + b * DS + i) * 1024 + (g * 4 + head) * 64 + ks * 32 + q * 8); }
        {
            const bf16_t* kp = p.kc + ((size_t)(bb * NCBS + 16 * w + l15) * 4 + g) * 64 + q * 8;
            const bf16x8 k0 = *(const bf16x8*)kp, k1 = *(const bf16x8*)(kp + 32);
#pragma unroll
            for (int rf = 0; rf < 2; ++rf) {
                f32x4 acc = (f32x4){0.f, 0.f, 0.f, 0.f}; acc = MFMA16(k0, qf[rf][0], acc); acc = MFMA16(k1, qf[rf][1], acc);
                const int R = rf * 16 + l15, tpos = PAST + (l15 & 7);
                for (int r = 0; r < 4; ++r) { const int n = 16 * w + 4 * q + r, cend = 16 * n + 31; Lsc[R * 128 + n] = (n < NCB_S && cend <= tpos) ? acc[r] - slope[rf] * (float)(tpos - cend) : NEG; }
            }
        }
        __syncthreads();
        {
            const int i = w, tpos = PAST + i, cur = tpos >> 6; float pt0 = 0.f, pt1 = 0.f;
            for (int hh = 0; hh < 4; ++hh) {
                const int R = hh * 8 + i; const float s0 = Lsc[R * 128 + lane], s1 = Lsc[R * 128 + 64 + lane];
                const float mx = wave_max(fmaxf(s0, s1));
                const float e0 = s0 > 0.5f * NEG ? exp2_fast(s0 - mx) : 0.f, e1 = s1 > 0.5f * NEG ? exp2_fast(s1 - mx) : 0.f;
                const float inv = 1.0f / fmaxf(wave_sum(e0 + e1), 1e-30f);
                Lsc[R * 128 + lane] = e0 * inv; Lsc[R * 128 + 64 + lane] = e1 * inv; pt0 += e0 * inv; pt1 += e1 * inv;
            }
            Lpt[i * 128 + lane] = pt0; Lpt[i * 128 + 64 + lane] = pt1;
            WAVE_SYNC();
            const int j = lane; float sv = NEG;
            if (j < NSELB_S && j <= cur) { float imp = 0.f; for (int n = 4 * j - 1; n <= 4 * j + 3; ++n) if (n >= 0 && n < NCB_S) imp += Lpt[i * 128 + n];
                const bool forced = (j == 0) || (j == cur) || (j == cur - 1); sv = imp + (forced ? 1.0e4f : 0.f); }
            Lscore[i * 64 + j] = sv;
            WAVE_SYNC();
            int rank = 0; for (int jj = 0; jj < NSELB_S; ++jj) { const float sj = Lscore[i * 64 + jj]; rank += (sj > sv || (sj == sv && jj < j)) ? 1 : 0; }
            const unsigned long long mask = __ballot(j < NSELB_S && j <= cur && rank < NSEL);
            if (lane == 0) Lsel[i] = mask;
        }
        __syncthreads();
        {
            const int df = w >> 1, rf = w & 1, R = rf * 16 + l15; f32x4 acc = (f32x4){0.f, 0.f, 0.f, 0.f};
#pragma unroll
            for (int ks = 0; ks < 4; ++ks) {
                const bf16x8 va = *(const bf16x8*)(p.vcT + ((size_t)(bb * 4 + g) * 64 + 16 * df + l15) * NCBS + 32 * ks + 8 * q);
                const float* pp = Lsc + R * 128 + 32 * ks + 8 * q;
                acc = MFMA16(va, pack8(*(const f32x4*)pp, *(const f32x4*)(pp + 4)), acc);
            }
            for (int r = 0; r < 4; ++r) Locmp[R * 64 + 16 * df + 4 * q + r] = acc[r];
        }
        unsigned long long U = 0ull;
        for (int i = 0; i < 8; ++i) U |= Lsel[i];
        const int nslc = __builtin_popcountll(U);
        bf16_t* Lvt = Lvt_all + w * (64 * 72);
        f32x4 outv = (f32x4){0.f, 0.f, 0.f, 0.f};
        const int cR = tid >> 4, cd = (tid & 15) * 4, chead = cR >> 3, ci = cR & 7;
        const float* gt = p.gates + ((size_t)TP + b * DS + ci) * 48 + (g * 4 + chead) * 3;
#pragma unroll 1
        for (int br = 0; br < 2; ++br) {
            float m[2], l[2]; f32x4 O[2][4];
#pragma unroll
            for (int rf = 0; rf < 2; ++rf) { m[rf] = NEG; l[rf] = 0.f; for (int df = 0; df < 4; ++df) O[rf][df] = (f32x4){0.f, 0.f, 0.f, 0.f}; }
            if (br == 0) {
#pragma unroll 1
                for (int u = w; u < nslc; u += 8) { unsigned long long rem = U; for (int k = 0; k < u; ++k) rem &= rem - 1ull; const int jb = __builtin_ctzll(rem); attn_sample_unit<0>(p, b, g, jb, lane, qf, slope, Lsel, Lvt, m, l, O); }
            } else {
#pragma unroll 1
                for (int u = (w + 8 - (nslc & 7)) & 7; u < NWB; u += 8) attn_sample_unit<1>(p, b, g, u, lane, qf, slope, Lsel, Lvt, m, l, O);
            }
            __syncthreads();
#pragma unroll
            for (int rf = 0; rf < 2; ++rf) {
                float lt = l[rf]; lt += __shfl_xor(lt, 16); lt += __shfl_xor(lt, 32);
                const int R = rf * 16 + l15;
                if (q == 0) { Lcomb[w * 2112 + 2048 + R] = m[rf]; Lcomb[w * 2112 + 2080 + R] = lt; }
#pragma unroll
                for (int df = 0; df < 4; ++df) { for (int r = 0; r < 4; ++r) Lcomb[w * 2112 + R * 64 + 16 * df + 4 * q + r] = O[rf][df][r]; }
            }
            __syncthreads();
            float M = NEG; for (int ww = 0; ww < 8; ++ww) M = fmaxf(M, Lcomb[ww * 2112 + 2048 + cR]);
            float L = 0.f; f32x4 o = (f32x4){0.f, 0.f, 0.f, 0.f};
            for (int ww = 0; ww < 8; ++ww) { const float sc = exp2_fast(Lcomb[ww * 2112 + 2048 + cR] - M); L += Lcomb[ww * 2112 + 2080 + cR] * sc; o += *(const f32x4*)(Lcomb + ww * 2112 + cR * 64 + cd) * sc; }
            outv += o * (gt[1 + br] / fmaxf(L, 1e-30f));
            __syncthreads();
        }
        outv += *(const f32x4*)(Locmp + cR * 64 + cd) * gt[0];
        *(bf16x4*)(p.ao + ((size_t)TP + b * DS + ci) * 1024 + (g * 4 + chead) * 64 + cd) = pack4(outv);
    }
}

DI void conv_fix_for_down(const Params& p, int l) {
    const int nM = (TP + 255) / 256, nN = D / 256;
#ifdef EMU
    for (int L = (int)blockIdx.x; L < nM * nN; L += gridDim.x) conv_fix_segments(p, l, (L / nN) * 4, 4);
#else
    pg8::StaticOrder S; S.init(nM * 256, D, (int)gridDim.x, (int)blockIdx.x);
    for (int i = 0;; ++i) { pg8::Unit u; if (!S.next(i, u)) break; conv_fix_segments(p, l, u.pm * 4, 4); }
#endif
    const int nMs = (TT - TP + 63) / 64, nNs = D / 64;
    for (int tile = blockIdx.x; tile < nMs * nNs; tile += gridDim.x) conv_fix_segments(p, l, TP / 64 + tile / nNs, 1);
#ifndef EMU
    asm volatile("s_waitcnt vmcnt(0)" ::: "memory");
#endif
    __syncthreads();
}
constexpr int LDS_BYTES = 147456;
constexpr int NPHASE = 22;
#define PHASE(k) if (p.ph_lo <= (k) && (k) < p.ph_hi)
#define SEAM(k) if (p.ph_lo <= (k) && (k) + 1 < p.ph_hi) grid_barrier(bar)
__global__ void __launch_bounds__(512, 2) mega(Params p) {
    char* lds = lds_base();
#ifdef EMU
    XcdBarrier bar{0};
#else
    if (threadIdx.x == 0) *(uint4*)(lds + LDS_BYTES - 16) = make_uint4(0u, 0u, 0u, 0u);
    __syncthreads();
    XcdBarrier bar = xcd_barrier_post(p.bar, (volatile LAS unsigned*)(lds + LDS_BYTES - 16));
#endif
    PHASE(0) phase_prologue(p, lds);
    SEAM(0);
    PHASE(1) { EpiAda e{p.mod, p.b_ada, p.b_ada_kv}; big_gemm(256, MODN, D, p.scb, p.Wada, e, lds); }
    SEAM(1);
    PHASE(2) phase_normmod<false>(p, true, p.g_mix, 0, D, p.hbuf, nullptr, 0, 0, nullptr);
    SEAM(2);
    PHASE(3) { EpiRetIn e{p.qb, p.kb, p.vb, p.sgb, p.kT, p.vT}; big_gemm(TT, RETP, D, p.hbuf, p.Wret_in, e, lds); }
    SEAM(3);
    PHASE(4) { phase_ret_prompt(p, lds); phase_ret_sample(p, lds); }
    SEAM(4);
    PHASE(5) phase_ret_act(p);
    SEAM(5);
    PHASE(6) { EpiResid e{&p, true, 2 * D}; big_gemm(TP, D, NV, p.actr, p.Wret_out, e, lds); __syncthreads(); gemm_wsplit(TP, TT, D, NV, p.actr, p.Wret_out, e, lds); }
    SEAM(6);
    PHASE(7) phase_normmod<false>(p, false, p.g_ffn, 3 * D, 4 * D, p.hbuf, nullptr, 0, 0, nullptr);
    SEAM(7);
    PHASE(8) { EpiFfnConv e{&p, 0, TT}; big_gemm_raw(TT, F2, D, p.hbuf, p.Wffn_in, e, lds); }
    SEAM(8);
    PHASE(10) { conv_fix_for_down(p, 0); EpiResid e{&p, false, 5 * D}; big_gemm(TP, D, DFF, p.actf, p.Wffn_out, e, lds); __syncthreads(); gemm_wsplit(TP, TT, D, DFF, p.actf, p.Wffn_out, e, lds); }
    SEAM(10);
    PHASE(11) phase_normmod<true>(p, false, p.g_mix + D, 6 * D, 7 * D, p.hbuf, p.g_kv, 12 * D, 13 * D, p.hkv);
    SEAM(11);
    PHASE(12) { EpiKv e0{&p}; EpiNsaIn e1{p.qb, p.gates}; big_gemm2(TT, D, p.hkv, p.Wkv, NKV, e0, p.hbuf, p.Wnsa_in, NNSA_PAD, e1, lds); }
    SEAM(12);
    PHASE(13) {
        { EpiZ1 e{p.Z1}; big_gemm(CROWS_P, 256, 1024, p.Acmp, p.Wc1, e, lds); }
        { EpiZ1 e{p.Z1 + (size_t)CROWS * 256}; big_gemm(CROWS_P, 256, 1024, p.Acmp + (size_t)CROWS_PAD * 1024, p.Wc1 + 256 * 1024, e, lds, 128); }
        __syncthreads();
        gemm_cmp_sample(p, 0, p.Wc1, p.Z1 + (size_t)CROWS_P * 256, lds);
        gemm_cmp_sample(p, 1, p.Wc1 + 256 * 1024, p.Z1 + (size_t)(CROWS + CROWS_P) * 256, lds);
    }
    SEAM(13);
    PHASE(14) {
        { EpiCmp2 e{p.kc, p.vcT, 0}; gemm_phase<true>(CROWS, 128, 128, p.Wc2, LoadCmp2{p.Z1, p.cbias}, e, lds); }
        { EpiCmp2 e{p.kc, p.vcT, 1}; gemm_phase<true>(CROWS, 128, 128, p.Wc2 + 128 * 128, LoadCmp2{p.Z1 + (size_t)CROWS * 256, p.cbias + 128}, e, lds); }
    }
    SEAM(14);
    PHASE(15) { phase_attn_sample(p, lds); __syncthreads(); phase_attn_prompt2(p, lds); }
    SEAM(15);
    PHASE(16) { EpiResid e{&p, false, 8 * D}; big_gemm(TP, D, D, p.ao, p.Wnsa_out, e, lds); __syncthreads(); gemm_wsplit(TP, TT, D, D, p.ao, p.Wnsa_out, e, lds); }
    SEAM(16);
    PHASE(17) phase_normmod<false>(p, false, p.g_ffn + D, 9 * D, 10 * D, p.hbuf, nullptr, 0, 0, nullptr);
    SEAM(17);
    PHASE(18) { EpiFfnConv e{&p, 1, TT}; big_gemm_raw(TT, F2, D, p.hbuf, p.Wffn_in + (size_t)F2 * D, e, lds); }
    SEAM(18);
    PHASE(20) { conv_fix_for_down(p, 1); EpiResid e{&p, false, 11 * D}; big_gemm(TP, D, DFF, p.actf, p.Wffn_out + (size_t)D * DFF, e, lds); __syncthreads(); gemm_wsplit(TP, TT, D, DFF, p.actf, p.Wffn_out + (size_t)D * DFF, e, lds); }
    SEAM(20);
    PHASE(21) phase_final_norm(p);
}

extern "C" void kernel_launch(void* const* d_in, const int* in_sizes, int n_in, void* d_out, int out_size, void* d_ws, size_t ws_size, hipStream_t stream) {
    Params p{};
    const float** fin = (const float**)&p.x_prompt;
    p.x_prompt = (const float*)d_in[0]; p.x_sample = (const float*)d_in[1]; p.c_prompt = (const float*)d_in[2]; p.c_sample = (const float*)d_in[3];
    p.state_ret = (const float*)d_in[4]; p.state_conv = (const float*)d_in[5]; p.cache_kv = (const float*)d_in[6]; p.state_win = (const float*)d_in[7];
    p.page_table = (const int*)d_in[8];
    p.w_ada = (const float*)d_in[9]; p.b_ada = (const float*)d_in[10]; p.g_mix = (const float*)d_in[11]; p.g_ffn = (const float*)d_in[12];
    p.w_ffn_in = (const float*)d_in[13]; p.conv_w = (const float*)d_in[14]; p.conv_b = (const float*)d_in[15]; p.w_ffn_out = (const float*)d_in[16];
    p.w_ret_in = (const float*)d_in[17]; p.w_ret_out = (const float*)d_in[18]; p.g_kv = (const float*)d_in[19]; p.w_ada_kv = (const float*)d_in[20];
    p.b_ada_kv = (const float*)d_in[21]; p.w_kv = (const float*)d_in[22]; p.pe_ck = (const float*)d_in[23]; p.pe_cv = (const float*)d_in[24];
    p.w_ck1 = (const float*)d_in[25]; p.w_ck2 = (const float*)d_in[26]; p.w_cv1 = (const float*)d_in[27]; p.w_cv2 = (const float*)d_in[28];
    p.w_nsa_in = (const float*)d_in[29]; p.w_nsa_out = (const float*)d_in[30]; p.g_final = (const float*)d_in[31];
    (void)fin;
    float* o = (float*)d_out;
    p.y_prompt = o; o += (size_t)TP * D; p.y_sample = o; o += (size_t)TS * D;
    p.ret_prompt = o; o += (size_t)BATCH * HA * DK * DV; p.ret_sample = o; o += (size_t)DB * HA * DK * DV;
    p.conv_prompt = o; o += (size_t)2 * BATCH * 2 * F2; p.conv_sample = o; o += (size_t)2 * DB * 2 * F2;
    p.kv_prompt = o; o += (size_t)TP * 1024; p.kv_sample = o; o += (size_t)TS * 1024;
    p.win_prompt = o; o += (size_t)BATCH * WINP * 512; p.win_sample = o; o += (size_t)DB * WINS * 512;
    WsAlloc A;
    p.bar = A.take<unsigned>(d_ws, XCD_BAR_WORDS);
    p.Wada = A.take<bf16_t>(d_ws, (size_t)MODN * D); p.Wret_in = A.take<bf16_t>(d_ws, (size_t)RETP * D); p.Wret_out = A.take<bf16_t>(d_ws, (size_t)D * NV);
    p.Wffn_in = A.take<bf16_t>(d_ws, (size_t)2 * F2 * D); p.Wffn_out = A.take<bf16_t>(d_ws, (size_t)2 * D * DFF); p.Wkv = A.take<bf16_t>(d_ws, (size_t)NKV * D);
    p.Wnsa_in = A.take<bf16_t>(d_ws, (size_t)NNSA_PAD * D); p.Wnsa_out = A.take<bf16_t>(d_ws, (size_t)D * D); p.Wc1 = A.take<bf16_t>(d_ws, (size_t)512 * 1024); p.Wc2 = A.take<bf16_t>(d_ws, 2 * 128 * 128);
    p.cbias = A.take<float>(d_ws, 256); p.mod = A.take<float>(d_ws, (size_t)NBAT * MODN); p.X = A.take<bf16_t>(d_ws, (size_t)TT * D);
    p.ssq = A.take<float>(d_ws, (size_t)TT * 32); p.gates = A.take<float>(d_ws, (size_t)TT * 48); p.Z1 = A.take<bf16_t>(d_ws, (size_t)2 * CROWS * 256); p.aof = A.take<float>(d_ws, (size_t)TP * D);
    p.Acmp = A.take<bf16_t>(d_ws, (size_t)2 * CROWS_PAD * 1024); p.scb = A.take<bf16_t>(d_ws, 256 * D); p.hbuf = A.take<bf16_t>(d_ws, (size_t)TT * D); p.hkv = A.take<bf16_t>(d_ws, (size_t)TT * D);
    p.qb = A.take<bf16_t>(d_ws, (size_t)TT * D); p.kb = A.take<bf16_t>(d_ws, (size_t)TT * D); p.vb = A.take<bf16_t>(d_ws, (size_t)TT * NV); p.sgb = A.take<bf16_t>(d_ws, (size_t)TT * NV);
    p.kT = A.take<bf16_t>(d_ws, (size_t)TP * NQ); p.vT = A.take<bf16_t>(d_ws, (size_t)TP * NV); p.obuf = A.take<bf16_t>(d_ws, (size_t)TT * NV); p.actr = A.take<bf16_t>(d_ws, (size_t)TT * NV);
    p.u = A.take<bf16_t>(d_ws, (size_t)TT * F2); p.uh = A.take<bf16_t>(d_ws, (size_t)((TT + 63) / 64 + 4) * 4 * F2); p.actf = A.take<bf16_t>(d_ws, (size_t)TT * DFF); p.kvb = A.take<bf16_t>(d_ws, (size_t)TP * NKV);
    p.vTs = A.take<bf16_t>(d_ws, (size_t)TP * 256); p.vTw = A.take<bf16_t>(d_ws, (size_t)TP * 256);
    p.kc = A.take<bf16_t>(d_ws, (size_t)NBAT * NCBS * 256); p.vcT = A.take<bf16_t>(d_ws, (size_t)NBAT * NCBS * 256); p.ao = A.take<bf16_t>(d_ws, (size_t)TT * D);
    if (A.off > ws_size) { fprintf(stderr, "kernel_launch: workspace too small (%zu > %zu)\n", A.off, ws_size); return; }
    hipMemsetAsync(p.bar, 0, XCD_BAR_WORDS * sizeof(unsigned), stream);
#ifdef EMU
    const int grid = 4;
    emu_dbg_register("mod", p.mod, (size_t)NBAT * MODN, 0);
    emu_dbg_register("hbuf", p.hbuf, (size_t)TT * D, 1);
    emu_dbg_register("ao", p.ao, (size_t)TT * D, 1); emu_dbg_register("nq", p.qb, (size_t)TT * D, 1); emu_dbg_register("gates", p.gates, (size_t)TT * 48, 0);
    emu_dbg_register("kc", p.kc, (size_t)NBAT * NCBS * 256, 1); emu_dbg_register("vcT", p.vcT, (size_t)NBAT * NCBS * 256, 1); emu_dbg_register("X1", p.X, (size_t)TT * D, 1);
    emu_dbg_register("obuf", p.obuf, (size_t)TT * NV, 1); emu_dbg_register("actr", p.actr, (size_t)TT * NV, 1);
    emu_dbg_register("actf1", p.actf, (size_t)TT * DFF, 1);
    emu_dbg_register("kb", p.kb, (size_t)TT * D, 1); emu_dbg_register("vb", p.vb, (size_t)TT * NV, 1); emu_dbg_register("sgb", p.sgb, (size_t)TT * NV, 1);
#else
    static int grid = 0;
    if (grid == 0) {
        int dev = 0, cus = 0;
        if (hipGetDevice(&dev) != hipSuccess || hipDeviceGetAttribute(&cus, hipDeviceAttributeMultiprocessorCount, dev) != hipSuccess) { fprintf(stderr, "kernel_launch: device query failed\n"); grid = -1; return; }
        if (hipFuncSetAttribute((const void*)mega, hipFuncAttributeMaxDynamicSharedMemorySize, LDS_BYTES) != hipSuccess) { fprintf(stderr, "kernel_launch: hipFuncSetAttribute failed\n"); grid = -1; return; }
        (void)hipGetLastError();
        grid = cus;
    }
    if (grid < 0) return;
#endif
    p.ph_lo = 0; p.ph_hi = NPHASE;
    LAUNCH(mega, grid, 512, LDS_BYTES, stream, p);
}
```

```cpp
#ifndef EMU
#include <hip/hip_runtime.h>
#include <cstdio>
#include <cstdint>
#endif

#ifndef CFG_BATCH
#define CFG_BATCH 8
#endif
#ifndef CFG_SEQ
#define CFG_SEQ 2048
#endif
#ifndef CFG_DB
#define CFG_DB 128
#endif
#ifndef CFG_PAST
#define CFG_PAST 2048
#endif
#ifndef CFG_NSEL
#define CFG_NSEL 16
#endif
#ifndef CFG_WINDOW
#define CFG_WINDOW 512
#endif
#ifndef CFG_DFF
#define CFG_DFF 2816
#endif
constexpr int BATCH = CFG_BATCH, SEQ = CFG_SEQ, DB = CFG_DB, PAST = CFG_PAST, NSEL = CFG_NSEL, WINDOW = CFG_WINDOW, DFF = CFG_DFF;
constexpr int D = 1024, DS = 8, PAGE = 128, NPAGES = PAST / PAGE;
constexpr int HA = 4, DK = 256, DV = 512, CH = 128, NQ = HA * DK, NV = HA * DV, RETP = 2 * NQ + 2 * NV;
constexpr int HB = 16, DH = 64, GB = 4, HPG = 4, F2 = 2 * DFF;
constexpr int TP = BATCH * SEQ, TS = DB * DS, TT = TP + TS, NBAT = BATCH + DB;
constexpr int NKV = 6 * GB * DH;
constexpr int NNSA = HB * DH + 3 * HB;
constexpr int NNSA_PAD = 1280;
constexpr int NPC_P = SEQ / 16, NPC_S = PAST / 16, NCB_P = NPC_P - 1, NCB_S = NPC_S - 1;
constexpr int NCBS = 128;
constexpr int CROWS_P = BATCH * NPC_P * 4, CROWS_S = DB * NPC_S * 4, CROWS = CROWS_P + CROWS_S, CROWS_PAD = (CROWS + 255) / 256 * 256;
constexpr int WBUF = (WINDOW < PAST ? WINDOW : PAST);
constexpr int WINP = (WINDOW < SEQ ? WINDOW : SEQ);
constexpr int WINS = (WINDOW < WBUF + DS ? WINDOW : WBUF + DS);
constexpr int NSELB_P = SEQ / 64;
constexpr int NSELB_S = (PAST + DS + 63) / 64;
constexpr float LOG2E = 1.4426950408889634f;
constexpr int MODN = 14 * D;
static_assert(SEQ % 256 == 0 && PAST % 128 == 0 && NPC_P <= 128 && NPC_S <= 128 && NSELB_P <= 32 && NSELB_S <= 33 && DFF % 64 == 0, "cfg");

typedef unsigned short bf16_t;
typedef short bf16x8 __attribute__((ext_vector_type(8)));
typedef short bf16x4 __attribute__((ext_vector_type(4)));
typedef float f32x4 __attribute__((ext_vector_type(4)));
typedef float f32x2 __attribute__((ext_vector_type(2)));
typedef unsigned u32x4 __attribute__((ext_vector_type(4)));
typedef unsigned u32x2 __attribute__((ext_vector_type(2)));
#define DI __device__ __forceinline__

#ifdef EMU
#define MFMA16(a, b, c) emu_mfma_16x16x32_bf16((a), (b), (c))
#define LAUNCH(kern, grid, block, lds, stream, ...) emu_launch(dim3(grid), dim3(block), lds, [=]() { kern(__VA_ARGS__); })
#define WAVE_SYNC() (void)__ballot(1)
#define OPAQUE(x) ((void)0)
#define UNIFORM(x) (x)
DI char* lds_base() { return (char*)emu_cur->blk->lds; }
#else
#define MFMA16(a, b, c) __builtin_amdgcn_mfma_f32_16x16x32_bf16((a), (b), (c), 0, 0, 0)
#define LAUNCH(kern, grid, block, lds, stream, ...) hipLaunchKernelGGL(kern, dim3(grid), dim3(block), lds, stream, __VA_ARGS__)
#define WAVE_SYNC() do { asm volatile("s_waitcnt lgkmcnt(0)" ::: "memory"); __builtin_amdgcn_wave_barrier(); asm volatile("" ::: "memory"); } while (0)
#define OPAQUE(x) asm volatile("" : "+v"(x))
#define UNIFORM(x) __builtin_amdgcn_readfirstlane(x)
extern __shared__ __attribute__((aligned(16))) char dyn_lds_[];
DI char* lds_base() { return dyn_lds_; }
#endif

DI bf16_t f2bf(float x) { unsigned u = __float_as_uint(x); u += 0x7fffu + ((u >> 16) & 1u); return (bf16_t)(u >> 16); }
DI float bf2f(bf16_t h) { return __uint_as_float(((unsigned)h) << 16); }
#ifdef EMU
DI unsigned pack2(float lo, float hi) { return (unsigned)f2bf(lo) | ((unsigned)f2bf(hi) << 16); }
#else
DI unsigned pack2(float lo, float hi) { unsigned r; asm("v_cvt_pk_bf16_f32 %0, %1, %2" : "=v"(r) : "v"(lo), "v"(hi)); return r; }
#endif
DI bf16x4 pack4(f32x4 v) { u32x2 r; r.x = pack2(v.x, v.y); r.y = pack2(v.z, v.w); return __builtin_bit_cast(bf16x4, r); }
DI bf16x8 pack8(f32x4 a, f32x4 b) { u32x4 r; r.x = pack2(a.x, a.y); r.y = pack2(a.z, a.w); r.z = pack2(b.x, b.y); r.w = pack2(b.z, b.w); return __builtin_bit_cast(bf16x8, r); }
DI f32x4 unpack4(bf16x4 v) { f32x4 r; for (int e = 0; e < 4; ++e) r[e] = bf2f((bf16_t)v[e]); return r; }
DI bf16x8 cat4(bf16x4 a, bf16x4 b) { return __builtin_shufflevector(a, b, 0, 1, 2, 3, 4, 5, 6, 7); }
#ifdef EMU
template <int N> DI float dpp_ror(float v) { const int lane = threadIdx.x & 63; return __shfl(v, (lane & ~15) | ((lane - N) & 15)); }
template <int N> DI float dpp_shr(float cur, float old) { const int lane = threadIdx.x & 63; const float t = __shfl(cur, (lane - N) & 63); return (lane & 15) >= N ? t : old; }
#else
template <int N> DI float dpp_ror(float v) { return __builtin_bit_cast(float, __builtin_amdgcn_update_dpp(0, __builtin_bit_cast(int, v), 0x120 + N, 0xf, 0xf, false)); }
template <int N> DI float dpp_shr(float cur, float old) { return __builtin_bit_cast(float, __builtin_amdgcn_update_dpp(__builtin_bit_cast(int, old), __builtin_bit_cast(int, cur), 0x110 + N, 0xf, 0xf, false)); }
#endif
DI float siluf(float x) { return x / (1.0f + __expf(-x)); }
#ifdef EMU
DI float silu_fast(float x) { return x / (1.0f + __expf(-x)); }
#else
DI float silu_fast(float x) { return x * __builtin_amdgcn_rcpf(1.0f + __builtin_amdgcn_exp2f(-1.4426950408889634f * x)); }
#endif
DI float sigmoidf(float x) { return 1.0f / (1.0f + __expf(-x)); }
#ifdef EMU
DI float sigmoid_fast(float x) { return 1.0f / (1.0f + __expf(-x)); }
#else
DI float sigmoid_fast(float x) { return __builtin_amdgcn_rcpf(1.0f + __builtin_amdgcn_exp2f(-1.4426950408889634f * x)); }
#endif
DI float wave_sum(float v) { v += __shfl_xor(v, 1); v += __shfl_xor(v, 2); v += __shfl_xor(v, 4); v += __shfl_xor(v, 8); v += __shfl_xor(v, 16); v += __shfl_xor(v, 32); return v; }
DI float wave_max(float v) { v = fmaxf(v, __shfl_xor(v, 1)); v = fmaxf(v, __shfl_xor(v, 2)); v = fmaxf(v, __shfl_xor(v, 4)); v = fmaxf(v, __shfl_xor(v, 8)); v = fmaxf(v, __shfl_xor(v, 16)); v = fmaxf(v, __shfl_xor(v, 32)); return v; }

#ifdef EMU
struct XcdBarrier { int dummy; };
#define XCD_BAR_WORDS 3456
DI void grid_barrier(const XcdBarrier&) { emu_grid_barrier(); }
#else
#define XB_TMO      128
#define XB_XCNT(j)  (256  + 64 * (j))
#define XB_XSUB(j)  (1280 + 64 * (j))
#define XB_XGEN(j)  (2304 + 64 * (j))
#define XB_TOP      3328
#define XB_TOPGEN   3392
#define XCD_BAR_WORDS 3456
#define XB_SPIN_CAP (1u << 22)
#define LAS __attribute__((address_space(3)))
__device__ __forceinline__ unsigned xb_ld(unsigned* p)              { return __hip_atomic_load(p, __ATOMIC_RELAXED, __HIP_MEMORY_SCOPE_AGENT); }
__device__ __forceinline__ unsigned xb_add(unsigned* p, unsigned v) { return __hip_atomic_fetch_add(p, v, __ATOMIC_RELAXED, __HIP_MEMORY_SCOPE_AGENT); }
__device__ __forceinline__ unsigned xb_xcc_id() { return (unsigned)__builtin_amdgcn_s_getreg((3 << 11) | 20) & 0xFu; }
#define XB_SPIN(cond, bar) do { unsigned _sp = 0; while (cond) { __builtin_amdgcn_s_sleep(1); \
    if ((++_sp & 255u) == 0u) { if (xb_ld(&(bar)[XB_TMO])) break; if (_sp > XB_SPIN_CAP) { atomicAdd(&(bar)[XB_TMO], 1u); break; } } } } while (0)
struct XcdBarrier { unsigned* bar; unsigned x; volatile LAS unsigned* st; };
__device__ __forceinline__ XcdBarrier xcd_barrier_post(unsigned* bar, volatile LAS unsigned* st) {
    XcdBarrier b; b.bar = bar; b.x = xb_xcc_id(); b.st = st;
    if (threadIdx.x == 0) (void)xb_add(&bar[XB_XCNT(b.x)], 1u);
    return b;
}
__device__ __forceinline__ void xcd_barrier_complete(unsigned* bar, unsigned x, unsigned& nloc, unsigned& nx) {
    const unsigned G = gridDim.x * gridDim.y * gridDim.z;
    unsigned sum, cnt, mine, sp = 0u;
    for (;;) {
        sum = 0u; cnt = 0u; mine = 0u;
#pragma unroll
        for (unsigned j = 0; j < 16; ++j) { const unsigned c = xb_ld(&bar[XB_XCNT(j)]); sum += c; cnt += (c > 0u) ? 1u : 0u; mine = (j == x) ? c : mine; }
        if (sum == G) break;
        __builtin_amdgcn_s_sleep(1);
        if ((++sp & 255u) == 0u) { if (xb_ld(&bar[XB_TMO])) break; if (sp > XB_SPIN_CAP) { atomicAdd(&bar[XB_TMO], 1u); break; } }
    }
    nloc = mine > 0u ? mine : 1u; nx = cnt > 0u ? cnt : 1u;
}
__device__ __forceinline__ void xcd_barrier(const XcdBarrier& b) {
    asm volatile("s_waitcnt vmcnt(0)" ::: "memory");
    __syncthreads();
    if (threadIdx.x == 0) {
        unsigned* bar = b.bar;
        __builtin_amdgcn_s_waitcnt(0);
        unsigned nloc = b.st[0], nx = b.st[1];
        if (nloc == 0u) { xcd_barrier_complete(bar, b.x, nloc, nx); b.st[0] = nloc; b.st[1] = nx; }
        const unsigned old = xb_add(&bar[XB_XSUB(b.x)], 1u);
        const unsigned gen = old / nloc;
        if (old + 1u == (gen + 1u) * nloc) {
            __builtin_amdgcn_fence(__ATOMIC_RELEASE, "agent");
            asm volatile("s_waitcnt vmcnt(0)" ::: "memory");
            const unsigned og = xb_add(&bar[XB_TOP], 1u);
            const unsigned tg = og / nx;
            if (og + 1u == (tg + 1u) * nx) xb_add(&bar[XB_TOPGEN], 1u);
            else XB_SPIN(xb_ld(&bar[XB_TOPGEN]) == tg, bar);
            __builtin_amdgcn_fence(__ATOMIC_ACQUIRE, "agent");
            xb_add(&bar[XB_XGEN(b.x)], 1u);
            asm volatile("s_waitcnt vmcnt(0)" ::: "memory");
        } else {
            XB_SPIN(xb_ld(&bar[XB_XGEN(b.x)]) == gen, bar);
            __builtin_amdgcn_fence(__ATOMIC_ACQUIRE, "agent");
            asm volatile("s_waitcnt vmcnt(0)" ::: "memory");
        }
    }
    __syncthreads();
}
DI void grid_barrier(const XcdBarrier& b) { xcd_barrier(b); }
#endif

struct Params {
    const float *x_prompt, *x_sample, *c_prompt, *c_sample, *state_ret, *state_conv, *cache_kv, *state_win;
    const int* page_table;
    const float *w_ada, *b_ada, *g_mix, *g_ffn, *w_ffn_in, *conv_w, *conv_b, *w_ffn_out, *w_ret_in, *w_ret_out, *g_kv, *w_ada_kv, *b_ada_kv, *w_kv,
        *pe_ck, *pe_cv, *w_ck1, *w_ck2, *w_cv1, *w_cv2, *w_nsa_in, *w_nsa_out, *g_final;
    float *y_prompt, *y_sample, *ret_prompt, *ret_sample, *conv_prompt, *conv_sample, *kv_prompt, *kv_sample, *win_prompt, *win_sample;
    unsigned* bar;
    bf16_t *Wada, *Wret_in, *Wret_out, *Wffn_in, *Wffn_out, *Wkv, *Wnsa_in, *Wnsa_out, *Wc1, *Wc2;
    float *cbias, *mod, *ssq, *gates, *aof; bf16_t *Z1, *X;
    bf16_t *Acmp, *scb, *hbuf, *hkv, *qb, *kb, *vb, *sgb, *kT, *vT, *obuf, *actr, *u, *actf, *kvb, *vTs, *vTw, *kc, *vcT, *ao, *uh;
    int ph_lo, ph_hi;
};

struct WsAlloc { size_t off = 0; template <class T> T* take(void* base, size_t n) { T* p = (T*)((char*)base + off); off += (n * sizeof(T) + 255) & ~(size_t)255; return p; } };

constexpr int GBM = 256, GBN = 128, GBK = 64, GPITCH = 72;
constexpr int GEMM_LDS = (GBM + GBN) * GPITCH * 2;
struct LoadRowMajor { const bf16_t* A; int lda; DI bf16x8 operator()(int row, int k0) const { return *(const bf16x8*)(A + (size_t)row * lda + k0); } };

template <bool TRANS, class LoadA, class Epi>
DI void gemm_phase(int M, int N, int K, const bf16_t* __restrict__ Bt, const LoadA& loadA, const Epi& epi, char* lds) {
    bf16_t* As = (bf16_t*)lds; bf16_t* Bs = As + GBM * GPITCH;
    const int tid = threadIdx.x, lane = tid & 63, w = tid >> 6, wm = w >> 1, wn = w & 1, l15 = lane & 15, q = lane >> 4;
    const int nM = (M + GBM - 1) / GBM, nN = N / GBN, nK = K / GBK;
    for (int tile = blockIdx.x; tile < nM * nN; tile += gridDim.x) {
        const int tm = tile / nN, tn = tile % nN;
        const int arow0 = tm * GBM, brow0 = tn * GBN;
        f32x4 acc[4][4];
#pragma unroll
        for (int i = 0; i < 4; ++i)
#pragma unroll
            for (int j = 0; j < 4; ++j) acc[i][j] = (f32x4){0.f, 0.f, 0.f, 0.f};
        bf16x8 pa[4], pb[2];
        int ar[4], ak[4];
#pragma unroll
        for (int i = 0; i < 4; ++i) { const int c = tid + 512 * i; ar[i] = c >> 3; ak[i] = (c & 7) * 8; }
#pragma unroll
        for (int i = 0; i < 4; ++i) { int r = arow0 + ar[i]; r = r < M ? r : M - 1; pa[i] = loadA(r, ak[i]); }
#pragma unroll
        for (int i = 0; i < 2; ++i) pb[i] = *(const bf16x8*)(Bt + (size_t)(brow0 + ar[i]) * K + ak[i]);
        for (int kt = 0; kt < nK; ++kt) {
            __syncthreads();
#pragma unroll
            for (int i = 0; i < 4; ++i) *(bf16x8*)(As + ar[i] * GPITCH + ak[i]) = pa[i];
#pragma unroll
            for (int i = 0; i < 2; ++i) *(bf16x8*)(Bs + ar[i] * GPITCH + ak[i]) = pb[i];
            __syncthreads();
            if (kt + 1 < nK) {
                const int k0 = (kt + 1) * GBK;
#pragma unroll
                for (int i = 0; i < 4; ++i) { int r = arow0 + ar[i]; r = r < M ? r : M - 1; pa[i] = loadA(r, k0 + ak[i]); }
#pragma unroll
                for (int i = 0; i < 2; ++i) pb[i] = *(const bf16x8*)(Bt + (size_t)(brow0 + ar[i]) * K + k0 + ak[i]);
            }
#pragma unroll
            for (int ks = 0; ks < 2; ++ks) {
                bf16x8 a[4], b[4];
#pragma unroll
                for (int i = 0; i < 4; ++i) a[i] = *(const bf16x8*)(As + (wm * 64 + i * 16 + l15) * GPITCH + ks * 32 + q * 8);
#pragma unroll
                for (int j = 0; j < 4; ++j) b[j] = *(const bf16x8*)(Bs + (wn * 64 + j * 16 + l15) * GPITCH + ks * 32 + q * 8);
#pragma unroll
                for (int i = 0; i < 4; ++i)
#pragma unroll
                    for (int j = 0; j < 4; ++j) acc[i][j] = TRANS ? MFMA16(b[j], a[i], acc[i][j]) : MFMA16(a[i], b[j], acc[i][j]);
            }
        }
#pragma unroll
        for (int i = 0; i < 4; ++i)
#pragma unroll
            for (int j = 0; j < 4; ++j) {
                if (TRANS) { const int m = arow0 + wm * 64 + i * 16 + l15, n = brow0 + wn * 64 + j * 16 + 4 * q; if (m < M) epi(m, n, acc[i][j]); }
                else { const int m = arow0 + wm * 64 + i * 16 + 4 * q, n = brow0 + wn * 64 + j * 16 + l15; if (m < M) epi(m, n, acc[i][j]); }
            }
    }
}

#ifndef EMU
namespace pg8 {
#define PG8_LAS __attribute__((address_space(3)))
typedef unsigned short bf16_t;
typedef short bf16x8 __attribute__((ext_vector_type(8)));
typedef float f32x4 __attribute__((ext_vector_type(4)));
typedef unsigned u32x4 __attribute__((ext_vector_type(4)));
constexpr int BM = 256, BK = 64, HALF = 128, HTB = HALF * BK * 2  , STAGE_BYTES = 8 * HTB, NXCD = 8, WGM = 8;

__host__ __device__ __forceinline__ int lds_byte(int r, int c) { const int st = (r >> 4) * 2 + (c >> 5), rr = r & 15, cc = c & 31, ob = rr * 64 + cc * 2; return st * 1024 + (ob ^ (((ob >> 9) & 1) << 5)); }
__host__ __device__ __forceinline__ void stage_rc(int b, int& R, int& C) { const int st = b / 1024, sb = b % 1024, swz = sb ^ (((sb >> 9) & 1) << 5); R = (st >> 1) * 16 + swz / 64; C = (st & 1) * 32 + (swz % 64) / 2; }
__host__ __device__ __forceinline__ int perm32(int rho) { const int n = rho >> 4, i = rho & 15; return 8 * (i >> 2) + 4 * n + (i & 3); }

struct Unit { int pm, pn; };
struct Gemm { const bf16_t* A; const bf16_t* Bt; int M, N, K; const bf16_t* A2 = nullptr; const bf16_t* Bt2 = nullptr; int nN0 = 1 << 30; };

struct StaticOrder {
    int nM, nN, nwg, G, c;
    __host__ __device__ void init(int M, int N, int G_, int c_) { nM = M / BM; nN = N / BM; nwg = nM * nN; G = G_; c = c_; }
    __host__ __device__ bool next(int i, Unit& u) const {
        const long L = (long)i * G + c; if (L >= nwg) return false;
        int wgid = (int)L; { const int q = nwg / NXCD, r = nwg % NXCD, xcd = wgid % NXCD, off = wgid / NXCD; wgid = (xcd < r ? xcd * (q + 1) : r * (q + 1) + (xcd - r) * q) + off; }
        const int nig = WGM * nN, gid = wgid / nig, fm = gid * WGM, gsz = (nM - fm) < WGM ? (nM - fm) : WGM;
        u.pm = fm + ((wgid % nig) % gsz); u.pn = (wgid % nig) / gsz; return true;
    }
    __device__ __forceinline__ void a_ready(const Unit&) const {}
    __device__ __forceinline__ void done(const Unit&) const {}
};

template <class Epi, class Sched, bool STAMP = false>
__device__ __forceinline__ void gemm_phase(PG8_LAS unsigned char* lds, const Gemm g, const Sched& S, const Epi& E, unsigned long long* stamps) {
    const int tid = threadIdx.x, wid = __builtin_amdgcn_readfirstlane(tid >> 6), lane = tid & 63, wr = wid >> 2, wc = wid & 3, fr = lane & 15, fq = lane >> 4;
    const int K = g.K, nt = K / BK;
    int ts_lo = 0, ts_hi = 0, nts = 0; const unsigned long long rt_entry = STAMP ? (unsigned long long)wall_clock64() : 0ull;
#define PG8_STAMP() do { if (STAMP && wid == 0 && nts < 64) { const unsigned long long _c = (unsigned long long)clock64(); \
        ts_lo = (lane == nts) ? (int)(unsigned)_c : ts_lo; ts_hi = (lane == nts) ? (int)(unsigned)(_c >> 32) : ts_hi; ++nts; } } while (0)
    PG8_STAMP();
    unsigned voffA[2], voffB[2];
#pragma unroll
    for (int i = 0; i < 2; ++i) { int R, C; stage_rc(tid * 16 + i * 8192, R, C); const int Rb = Epi::PERM ? ((R & ~31) + perm32(R & 31)) : R;
        voffA[i] = (unsigned)(R * K + C) * 2u; voffB[i] = (unsigned)(Rb * K + C) * 2u; }
    const size_t kstep = (size_t)(BK * 2);
    const size_t hstep = (size_t)HALF * K * 2;
    const size_t tstep = 2 * hstep;
    const unsigned ldsw = (unsigned)wid * 1024u;
    const int aoff = lds_byte(wr * 64 + fr, fq * 8), boff = lds_byte(wc * 32 + fr, fq * 8);
#define PG8_SA(b, h) (((b) * 2 + (h)) * HTB)
#define PG8_SB(b, h) ((4 + (b) * 2 + (h)) * HTB)
#define PG8_STAGE(bufoff, gbase, voff) do { _Pragma("unroll") for (int _i = 0; _i < 2; ++_i) \
        __builtin_amdgcn_global_load_lds((const unsigned*)((const char*)(gbase) + (voff)[_i]), (PG8_LAS unsigned*)(lds + (bufoff) + ldsw + _i * 8192), 16, 0, 0); } while (0)
#define PG8_LDA(dst, b, h) do { _Pragma("unroll") for (int m = 0; m < 4; ++m) _Pragma("unroll") for (int k = 0; k < 2; ++k) dst[m][k] = *(const PG8_LAS bf16x8*)(lds + PG8_SA(b, h) + aoff + m * 2048 + k * 1024); } while (0)
#define PG8_LDB(dst, b, h) do { _Pragma("unroll") for (int n = 0; n < 2; ++n) _Pragma("unroll") for (int k = 0; k < 2; ++k) dst[n][k] = *(const PG8_LAS bf16x8*)(lds + PG8_SB(b, h) + boff + n * 2048 + k * 1024); } while (0)
#define PG8_MMA(ai, bj, At, Bt) do { __builtin_amdgcn_s_setprio(1); _Pragma("unroll") for (int m = 0; m < 4; ++m) _Pragma("unroll") for (int n = 0; n < 2; ++n) _Pragma("unroll") for (int k = 0; k < 2; ++k) \
        acc[ai][bj][m][n] = __builtin_amdgcn_mfma_f32_16x16x32_bf16(Bt[n][k], At[m][k], acc[ai][bj][m][n], 0, 0, 0); __builtin_amdgcn_s_setprio(0); } while (0)
#define PG8_WAIT_V(n) asm volatile("s_waitcnt vmcnt(" #n ")" ::: "memory")
#define PG8_WAIT_L(n) asm volatile("s_waitcnt lgkmcnt(" #n ")" ::: "memory")
#define PG8_BAR __builtin_amdgcn_s_barrier()
#define PG8_SCHED __builtin_amdgcn_sched_barrier(0)
    Unit cur, nxt; int ui = 0;
    if (!S.next(0, cur)) return;
    f32x4 acc[2][2][4][2];
#pragma unroll
    for (int a = 0; a < 2; ++a)
#pragma unroll
        for (int b = 0; b < 2; ++b)
#pragma unroll
            for (int m = 0; m < 4; ++m)
#pragma unroll
                for (int n = 0; n < 2; ++n) acc[a][b][m][n] = (f32x4){0.f, 0.f, 0.f, 0.f};
    bf16x8 At[4][2], B0[2][2], B1[2][2];
    const char* cA = (const char*)(cur.pn < g.nN0 ? g.A : g.A2) + (size_t)cur.pm * tstep; const char* cB = cur.pn < g.nN0 ? (const char*)g.Bt + (size_t)cur.pn * tstep : (const char*)g.Bt2 + (size_t)(cur.pn - g.nN0) * tstep;
    S.a_ready(cur);
    PG8_STAGE(PG8_SB(0, 0), cB, voffB); PG8_STAGE(PG8_SA(0, 0), cA, voffA); PG8_STAGE(PG8_SB(0, 1), cB + hstep, voffB); PG8_STAGE(PG8_SA(0, 1), cA + hstep, voffA);
    if (wr == 1) PG8_BAR;
    PG8_WAIT_V(4); PG8_BAR;
    PG8_STAGE(PG8_SB(1, 0), cB + kstep, voffB); PG8_STAGE(PG8_SA(1, 0), cA + kstep, voffA); PG8_STAGE(PG8_SB(1, 1), cB + hstep + kstep, voffB);
    PG8_WAIT_V(6); PG8_BAR;
    PG8_STAMP();
    for (;;) {
        const bool has_next = S.next(ui + 1, nxt);
        const char* nA = has_next ? (const char*)(nxt.pn < g.nN0 ? g.A : g.A2) + (size_t)nxt.pm * tstep : cA; const char* nB = has_next ? (nxt.pn < g.nN0 ? (const char*)g.Bt + (size_t)nxt.pn * tstep : (const char*)g.Bt2 + (size_t)(nxt.pn - g.nN0) * tstep) : cB;
        for (int t = 0; t < nt; t += 2) {
            const bool last = (t == nt - 2);
            const char* a1 = cA + (size_t)(t + 1) * kstep;
            const char* a2 = last ? nA : cA + (size_t)(t + 2) * kstep; const char* b2 = last ? nB : cB + (size_t)(t + 2) * kstep;
            const char* a3 = a2 + kstep; const char* b3 = b2 + kstep;
            if (last && has_next) S.a_ready(nxt);
            PG8_LDB(B0, 0, 0); PG8_SCHED; PG8_LDA(At, 0, 0); PG8_STAGE(PG8_SA(1, 1), a1 + hstep, voffA);
            PG8_WAIT_L(8); PG8_BAR; PG8_WAIT_L(0); PG8_MMA(0, 0, At, B0); PG8_BAR; PG8_SCHED;
            PG8_LDB(B1, 0, 1); PG8_STAGE(PG8_SB(0, 0), b2, voffB);
            PG8_BAR; PG8_WAIT_L(0); PG8_MMA(0, 1, At, B1); PG8_BAR;
            PG8_LDA(At, 0, 1); PG8_STAGE(PG8_SA(0, 0), a2, voffA);
            PG8_BAR; PG8_WAIT_L(0); PG8_MMA(1, 0, At, B0); PG8_BAR; PG8_SCHED;
            PG8_STAGE(PG8_SB(0, 1), b2 + hstep, voffB);
            PG8_WAIT_V(6); PG8_BAR; PG8_MMA(1, 1, At, B1); PG8_BAR;
            PG8_LDB(B0, 1, 0); PG8_SCHED; PG8_LDA(At, 1, 0); PG8_STAGE(PG8_SA(0, 1), a2 + hstep, voffA);
            PG8_WAIT_L(8); PG8_BAR; PG8_WAIT_L(0); PG8_MMA(0, 0, At, B0); PG8_BAR; PG8_SCHED;
            PG8_LDB(B1, 1, 1); PG8_STAGE(PG8_SB(1, 0), b3, voffB);
            PG8_BAR; PG8_WAIT_L(0); PG8_MMA(0, 1, At, B1); PG8_BAR;
            PG8_LDA(At, 1, 1); PG8_STAGE(PG8_SA(1, 0), a3, voffA);
            PG8_BAR; PG8_WAIT_L(0); PG8_MMA(1, 0, At, B0); PG8_BAR; PG8_SCHED;
            PG8_STAGE(PG8_SB(1, 1), b3 + hstep, voffB);
            PG8_WAIT_V(6); PG8_BAR; PG8_MMA(1, 1, At, B1); PG8_BAR;
        }
        PG8_STAMP();
        if constexpr (!Epi::AFTER_DRAIN) { E(acc, cur, wr, wc, fr, fq); S.done(cur); }
        PG8_STAMP();
        if (!has_next) break;
#pragma unroll
        for (int a = 0; a < 2; ++a)
#pragma unroll
            for (int b = 0; b < 2; ++b)
#pragma unroll
                for (int m = 0; m < 4; ++m)
#pragma unroll
                    for (int n = 0; n < 2; ++n) acc[a][b][m][n] = (f32x4){0.f, 0.f, 0.f, 0.f};
        cur = nxt; cA = nA; cB = nB; ++ui;
    }
    PG8_WAIT_V(0);
    if (wr == 0) PG8_BAR;
    PG8_BAR;
    if constexpr (Epi::AFTER_DRAIN) { E.fused(acc, cur, wr, wc, fr, fq, lds, wid, lane); S.done(cur); }
    PG8_STAMP();
    if (STAMP && wid == 0) { stamps[lane] = lane < nts ? (((unsigned long long)(unsigned)ts_hi << 32) | (unsigned)ts_lo) : 0ull;
        if (lane == 62) stamps[62] = rt_entry; if (lane == 63) stamps[63] = (unsigned long long)wall_clock64(); }
#undef PG8_STAMP
#undef PG8_SA
#undef PG8_SB
#undef PG8_STAGE
#undef PG8_LDA
#undef PG8_LDB
#undef PG8_MMA
#undef PG8_WAIT_V
#undef PG8_WAIT_L
#undef PG8_BAR
#undef PG8_SCHED
}
}
#else
namespace pg8 {
typedef ::f32x4 f32x4;
struct Unit { int pm, pn; };
struct Gemm { const bf16_t* A; const bf16_t* Bt; int M, N, K; const bf16_t* A2 = nullptr; const bf16_t* Bt2 = nullptr; int nN0 = 1 << 30; };
inline int perm32(int rho) { const int n = rho >> 4, i = rho & 15; return 8 * (i >> 2) + 4 * n + (i & 3); }
template <class Epi> inline void gemm_phase_emu(const Gemm g, const Epi& E, int rot) {
    const int tid = threadIdx.x, lane = tid & 63, wid = tid >> 6, wr = wid >> 2, wc = wid & 3, fr = lane & 15, fq = lane >> 4;
    const int nM = g.M / 256, nN = g.N / 256;
    for (int L = (int)((blockIdx.x + rot) % gridDim.x); L < nM * nN; L += gridDim.x) {
        Unit u{L / nN, L % nN};
        f32x4 acc[2][2][4][2];
        for (int a = 0; a < 2; ++a) for (int b = 0; b < 2; ++b) for (int m = 0; m < 4; ++m) for (int n = 0; n < 2; ++n) acc[a][b][m][n] = (f32x4){0.f, 0.f, 0.f, 0.f};
        for (int kk = 0; kk < g.K / 32; ++kk)
            for (int a = 0; a < 2; ++a) for (int m = 0; m < 4; ++m) {
                const bf16x8 af = *(const bf16x8*)((u.pn < g.nN0 ? g.A : g.A2) + (size_t)(u.pm * 256 + a * 128 + wr * 64 + m * 16 + fr) * g.K + kk * 32 + fq * 8);
                for (int b = 0; b < 2; ++b) for (int n = 0; n < 2; ++n) {
                    const int rho = 16 * n + fr, cw = Epi::PERM ? perm32(rho) : rho;
                    const bf16x8 bf = *(const bf16x8*)((u.pn < g.nN0 ? g.Bt + (size_t)(u.pn * 256) * g.K : g.Bt2 + (size_t)((u.pn - g.nN0) * 256) * g.K) + (size_t)(b * 128 + wc * 32 + cw) * g.K + kk * 32 + fq * 8);
                    acc[a][b][m][n] = MFMA16(bf, af, acc[a][b][m][n]);
                }
            }
        E(acc, u, wr, wc, fr, fq);
    }
}
}
#endif
template <class Epi> struct Pg8Epi {
    static constexpr bool PERM = Epi::WIDE8, AFTER_DRAIN = false;
    const Epi* e; int M;
    __device__ __forceinline__ void operator()(const pg8::f32x4 (&acc)[2][2][4][2], const pg8::Unit& u, int wr, int wc, int fr, int fq) const {
#pragma unroll
        for (int ai = 0; ai < 2; ++ai)
#pragma unroll
            for (int m = 0; m < 4; ++m) {
                const int row = u.pm * 256 + ai * 128 + wr * 64 + m * 16 + fr;
                if (row < M) {
#pragma unroll
                    for (int bj = 0; bj < 2; ++bj) {
                        if constexpr (Epi::WIDE8) e->wide(row, u.pn * 256 + bj * 128 + wc * 32 + 8 * fq, acc[ai][bj][m][0], acc[ai][bj][m][1]);
                        else {
#pragma unroll
                            for (int n = 0; n < 2; ++n) (*e)(row, u.pn * 256 + bj * 128 + wc * 32 + n * 16 + 4 * fq, acc[ai][bj][m][n]);
                        }
                    }
                }
            }
    }
};
template <class PgEpi>
DI void big_gemm_raw(int M, int N, int K, const bf16_t* A, const bf16_t* Bt, const PgEpi& E, char* lds, int rot = 0) {
    pg8::Gemm g{A, Bt, (M + 255) / 256 * 256, N, K};
#ifdef EMU
    pg8::gemm_phase_emu(g, E, rot);
#else
    pg8::StaticOrder S; S.init(g.M, N, (int)gridDim.x, (int)((blockIdx.x + rot) % gridDim.x));
    pg8::gemm_phase<PgEpi, pg8::StaticOrder, false>((PG8_LAS unsigned char*)lds, g, S, E, nullptr);
#endif
}
template <class Epi0, class Epi1> struct Pg8Epi2 {
    static constexpr bool PERM = false, AFTER_DRAIN = false;
    const Epi0* e0; const Epi1* e1; int M, nN0;
    __device__ __forceinline__ void operator()(const pg8::f32x4 (&acc)[2][2][4][2], const pg8::Unit& u, int wr, int wc, int fr, int fq) const {
        const bool first = u.pn < nN0; const int cbase = (first ? u.pn : u.pn - nN0) * 256;
#pragma unroll
        for (int ai = 0; ai < 2; ++ai)
#pragma unroll
            for (int m = 0; m < 4; ++m) {
                const int row = u.pm * 256 + ai * 128 + wr * 64 + m * 16 + fr;
                if (row < M) {
#pragma unroll
                    for (int bj = 0; bj < 2; ++bj)
#pragma unroll
                        for (int n = 0; n < 2; ++n) { const int col = cbase + bj * 128 + wc * 32 + n * 16 + 4 * fq; if (first) (*e0)(row, col, acc[ai][bj][m][n]); else (*e1)(row, col, acc[ai][bj][m][n]); }
                }
            }
    }
};
template <class Epi0, class Epi1>
DI void big_gemm2(int M, int K, const bf16_t* A0, const bf16_t* Bt0, int N0, const Epi0& e0, const bf16_t* A1, const bf16_t* Bt1, int N1, const Epi1& e1, char* lds) {
    Pg8Epi2<Epi0, Epi1> E{&e0, &e1, M, N0 / 256};
    pg8::Gemm g{A0, Bt0, (M + 255) / 256 * 256, N0 + N1, K, A1, Bt1, N0 / 256};
#ifdef EMU
    pg8::gemm_phase_emu(g, E, 0);
#else
    pg8::StaticOrder S; S.init(g.M, g.N, (int)gridDim.x, (int)blockIdx.x);
    pg8::gemm_phase<Pg8Epi2<Epi0, Epi1>, pg8::StaticOrder, false>((PG8_LAS unsigned char*)lds, g, S, E, nullptr);
#endif
}
template <class Epi>
DI void big_gemm(int M, int N, int K, const bf16_t* A, const bf16_t* Bt, const Epi& epi, char* lds, int rot = 0) {
    Pg8Epi<Epi> E{&epi, M};
    big_gemm_raw(M, N, K, A, Bt, E, lds, rot);
}

DI void gemm_cmp_sample(const Params& p, int c, const bf16_t* __restrict__ Wt, bf16_t* __restrict__ Zout, char* lds) {
    constexpr int PA = 72;
    bf16_t* As = (bf16_t*)lds; bf16_t* Bs = As + 128 * PA;
    const int tid = threadIdx.x, lane = tid & 63, w = tid >> 6, wm = w >> 2, wn = w & 3, l15 = lane & 15, q = lane >> 4;
    constexpr int NTILE = CROWS_S / 128;
    static_assert(CROWS_S % 128 == 0, "sample compress rows");
    for (int tile = blockIdx.x; tile < NTILE; tile += gridDim.x) {
        const int r0 = tile * 128;
        const float* abase[2]; unsigned boff[4];
#pragma unroll
        for (int i = 0; i < 2; ++i) { const int cc = tid + 512 * i, r = r0 + (cc >> 3), g = r & 3, j = (r >> 2) % NPC_S, bs = (r >> 2) / NPC_S;
            abase[i] = p.cache_kv + ((size_t)p.page_table[bs * NPAGES + (j >> 3)] * PAGE + ((16 * j) & 127)) * 1024 + c * 256 + g * 64 + (cc & 7) * 8; }
#pragma unroll
        for (int i = 0; i < 4; ++i) { const int cc = tid + 512 * i; boff[i] = (unsigned)((cc >> 3) * 1024 + (cc & 7) * 8); }
        f32x4 ra[2][2][2]; bf16x8 rb[4];
#pragma unroll
        for (int st = 0; st < 2; ++st)
#pragma unroll
            for (int i = 0; i < 2; ++i) { ra[st][i][0] = *(const f32x4*)(abase[i] + st * 1024); ra[st][i][1] = *(const f32x4*)(abase[i] + st * 1024 + 4); }
#pragma unroll
        for (int i = 0; i < 4; ++i) rb[i] = *(const bf16x8*)(Wt + boff[i]);
        f32x4 acc[4][4];
#pragma unroll
        for (int i = 0; i < 4; ++i)
#pragma unroll
            for (int j = 0; j < 4; ++j) acc[i][j] = (f32x4){0.f, 0.f, 0.f, 0.f};
#pragma unroll 1
        for (int kt2 = 0; kt2 < 8; ++kt2) {
#pragma unroll
            for (int st = 0; st < 2; ++st) {
                const int kt = 2 * kt2 + st;
                __syncthreads();
#pragma unroll
                for (int i = 0; i < 2; ++i) { const int cc = tid + 512 * i; *(bf16x8*)(As + (cc >> 3) * PA + (cc & 7) * 8) = pack8(ra[st][i][0], ra[st][i][1]); }
#pragma unroll
                for (int i = 0; i < 4; ++i) { const int cc = tid + 512 * i; *(bf16x8*)(Bs + (cc >> 3) * PA + (cc & 7) * 8) = rb[i]; }
                __syncthreads();
                if (kt + 2 < 16) {
#pragma unroll
                    for (int i = 0; i < 2; ++i) { ra[st][i][0] = *(const f32x4*)(abase[i] + (kt + 2) * 1024); ra[st][i][1] = *(const f32x4*)(abase[i] + (kt + 2) * 1024 + 4); }
                }
                if (kt + 1 < 16) {
#pragma unroll
                    for (int i = 0; i < 4; ++i) rb[i] = *(const bf16x8*)(Wt + (boff[i] + (unsigned)((kt + 1) * 64)));
                }
#pragma unroll
                for (int ks = 0; ks < 2; ++ks) {
                    bf16x8 a[4], b[4];
#pragma unroll
                    for (int i = 0; i < 4; ++i) a[i] = *(const bf16x8*)(As + (wm * 64 + i * 16 + l15) * PA + ks * 32 + q * 8);
#pragma unroll
                    for (int j = 0; j < 4; ++j) b[j] = *(const bf16x8*)(Bs + (wn * 64 + j * 16 + l15) * PA + ks * 32 + q * 8);
#pragma unroll
                    for (int i = 0; i < 4; ++i)
#pragma unroll
                        for (int j = 0; j < 4; ++j) acc[i][j] = MFMA16(b[j], a[i], acc[i][j]);
                }
            }
        }
#pragma unroll
        for (int i = 0; i < 4; ++i)
#pragma unroll
            for (int j = 0; j < 4; ++j) *(bf16x4*)(Zout + (size_t)(r0 + wm * 64 + i * 16 + l15) * 256 + wn * 64 + j * 16 + 4 * q) = pack4(acc[i][j]);
    }
}

template <class Epi>
DI void gemm_wsplit(int m0, int M, int N, int K, const bf16_t* A, const bf16_t* Bt, const Epi& epi, char* lds) {
    float* red = (float*)lds;
    const int tid = threadIdx.x, lane = tid & 63, w = UNIFORM(tid >> 6), l15 = lane & 15, q = lane >> 4;
    const int nM = (M - m0 + 63) / 64, nN = N / 64, kw = K / 8, nks = kw / 32;
    for (int tile = blockIdx.x; tile < nM * nN; tile += gridDim.x) {
        const int r0 = m0 + (tile / nN) * 64, n0 = (tile % nN) * 64;
        f32x4 acc[4][4];
#pragma unroll
        for (int i = 0; i < 4; ++i)
#pragma unroll
            for (int j = 0; j < 4; ++j) acc[i][j] = (f32x4){0.f, 0.f, 0.f, 0.f};
        const bf16_t* ap[4]; const bf16_t* bp[4];
#pragma unroll
        for (int i = 0; i < 4; ++i) { int r = r0 + 16 * i + l15; r = r < M ? r : M - 1; ap[i] = A + (size_t)r * K + w * kw + q * 8; bp[i] = Bt + (size_t)(n0 + 16 * i + l15) * K + w * kw + q * 8; }
#pragma unroll 2
        for (int ks = 0; ks < nks; ++ks) {
            bf16x8 a[4], b[4];
#pragma unroll
            for (int i = 0; i < 4; ++i) { a[i] = *(const bf16x8*)(ap[i] + ks * 32); b[i] = *(const bf16x8*)(bp[i] + ks * 32); }
#pragma unroll
            for (int i = 0; i < 4; ++i)
#pragma unroll
                for (int j = 0; j < 4; ++j) acc[i][j] = MFMA16(b[j], a[i], acc[i][j]);
        }
        __syncthreads();
#pragma unroll
        for (int i = 0; i < 4; ++i)
#pragma unroll
            for (int j = 0; j < 4; ++j) *(f32x4*)(red + w * 4096 + (16 * i + l15) * 64 + 16 * j + 4 * q) = acc[i][j];
        __syncthreads();
        const int m = tid >> 3, n8 = (tid & 7) * 8;
        f32x4 v0 = (f32x4){0.f, 0.f, 0.f, 0.f}, v1 = v0;
#pragma unroll
        for (int ww = 0; ww < 8; ++ww) { v0 += *(const f32x4*)(red + ww * 4096 + m * 64 + n8); v1 += *(const f32x4*)(red + ww * 4096 + m * 64 + n8 + 4); }
        if (r0 + m < M) { epi(r0 + m, n0 + n8, v0); epi(r0 + m, n0 + n8 + 4, v1); }
    }
}

DI int tok_batch(int tok) { return tok < TP ? tok / SEQ : BATCH + (tok - TP) / DS; }
DI const float* x_in_row(const Params& p, int tok) { return tok < TP ? p.x_prompt + (size_t)tok * D : p.x_sample + (size_t)(tok - TP) * D; }

struct CvtJob { const float* src; bf16_t* dst; int K, N, ld; float scale; int slo, shi; int ilv; };
constexpr int NCVT = 16;
DI CvtJob cvt_job(const Params& p, int j) {
    CvtJob c; c.scale = 1.f; c.slo = 0; c.shi = 0; c.ilv = 0;
    switch (j) {
    case 0:  c = {p.w_ada, p.Wada, D, 6 * D, 6 * D, 1.f, 0, 0, 0}; break;
    case 1:  c = {p.w_ada + (size_t)D * 6 * D, p.Wada + (size_t)6 * D * D, D, 6 * D, 6 * D, 1.f, 0, 0, 0}; break;
    case 2:  c = {p.w_ada_kv, p.Wada + (size_t)12 * D * D, D, 2 * D, 2 * D, 1.f, 0, 0, 0}; break;
    case 3:  c = {p.w_ret_in, p.Wret_in, D, RETP, RETP, 0.0625f, NQ, 2 * NQ, 0}; break;
    case 4:  c = {p.w_ret_out, p.Wret_out, NV, D, D, 1.f, 0, 0, 0}; break;
    case 5:  c = {p.w_ffn_in, p.Wffn_in, D, F2, F2, 1.f, 0, 0, 1}; break;
    case 6:  c = {p.w_ffn_in + (size_t)D * F2, p.Wffn_in + (size_t)F2 * D, D, F2, F2, 1.f, 0, 0, 1}; break;
    case 7:  c = {p.w_ffn_out, p.Wffn_out, DFF, D, D, 1.f, 0, 0, 0}; break;
    case 8:  c = {p.w_ffn_out + (size_t)DFF * D, p.Wffn_out + (size_t)D * DFF, DFF, D, D, 1.f, 0, 0, 0}; break;
    case 9:  c = {p.w_kv, p.Wkv, D, NKV, NKV, 1.f, 0, 0, 0}; break;
    case 10: c = {p.w_nsa_in, p.Wnsa_in, D, NNSA, NNSA, 0.125f * LOG2E, 0, HB * DH, 0}; break;
    case 11: c = {p.w_nsa_out, p.Wnsa_out, D, D, D, 1.f, 0, 0, 0}; break;
    case 12: c = {p.w_ck1, p.Wc1, 1024, 128, 128, 1.f, 0, 0, 0}; break;
    case 13: c = {p.w_ck1 + 1024 * 128, p.Wc1 + 128 * 1024, 1024, 128, 128, 1.f, 0, 0, 0}; break;
    case 14: c = {p.w_cv1, p.Wc1 + 256 * 1024, 1024, 128, 128, 1.f, 0, 0, 0}; break;
    default: c = {p.w_cv1 + 1024 * 128, p.Wc1 + 384 * 1024, 1024, 128, 128, 1.f, 0, 0, 0}; break;
    }
    return c;
}
constexpr int CVT_TN = 256;
DI void cvt_locate(const Params& p, int t, CvtJob& c, int& k0, int& n0) {
    int j = 0, rem = t;
    for (;; ++j) { c = cvt_job(p, j); const int n = (c.K / 64) * ((c.N + CVT_TN - 1) / CVT_TN); if (rem < n || j == NCVT - 1) break; rem -= n; }
    const int nkt = c.K / 64; k0 = (rem % nkt) * 64; n0 = (rem / nkt) * CVT_TN;
}
DI f32x4 cvt_load(const CvtJob& c, int k0, int n0, int r, int c4) {
    f32x4 v = (f32x4){0.f, 0.f, 0.f, 0.f};
    if (n0 + c4 + 3 < c.N) v = *(const f32x4*)(c.src + (size_t)(k0 + r) * c.ld + n0 + c4);
    else { for (int e = 0; e < 4; ++e) if (n0 + c4 + e < c.N) v[e] = c.src[(size_t)(k0 + r) * c.ld + n0 + c4 + e]; }
    return v;
}
DI void phase_prologue(const Params& p, char* lds) {
    float* tl = (float*)lds;
    const int tid = threadIdx.x, lane = tid & 63;
    const int gtid = blockIdx.x * 512 + tid, gn = gridDim.x * 512, gw = blockIdx.x * 8 + (tid >> 6), nw = gridDim.x * 8;
    {
        constexpr size_t NV4 = (size_t)DB * (WINS - DS) * 128;
        for (size_t i0 = (size_t)gtid * 8; i0 < NV4; i0 += (size_t)gn * 8) {
            f32x4 v[8];
#pragma unroll
            for (int u = 0; u < 8; ++u) { const size_t i = i0 + u; if (i < NV4) { const size_t b = i / ((size_t)(WINS - DS) * 128), r = i % ((size_t)(WINS - DS) * 128); v[u] = *(const f32x4*)(p.state_win + b * WBUF * 512 + (size_t)(WBUF + DS - WINS) * 512 + r * 4); } }
#pragma unroll
            for (int u = 0; u < 8; ++u) { const size_t i = i0 + u; if (i < NV4) { const size_t b = i / ((size_t)(WINS - DS) * 128), r = i % ((size_t)(WINS - DS) * 128); *(f32x4*)(p.win_sample + b * WINS * 512 + r * 4) = v[u]; } }
        }
    }
    int total = 0;
    for (int j = 0; j < NCVT; ++j) { const CvtJob c = cvt_job(p, j); total += (c.K / 64) * ((c.N + CVT_TN - 1) / CVT_TN); }
    {
        const int r0 = tid >> 6, c4 = (tid & 63) * 4;
        for (int t = blockIdx.x; t < total; t += gridDim.x) {
            CvtJob c; int k0, n0; cvt_locate(p, t, c, k0, n0);
            f32x4 v[8];
#pragma unroll
            for (int i = 0; i < 8; ++i) v[i] = cvt_load(c, k0, n0, r0 + 8 * i, c4);
            __syncthreads();
#pragma unroll
            for (int i = 0; i < 8; ++i) { for (int e = 0; e < 4; ++e) tl[(r0 + 8 * i) * 257 + c4 + e] = v[i][e]; }
            __syncthreads();
#pragma unroll
            for (int i = 0; i < 4; ++i) {
                const int cc = tid + 512 * i, nr = cc >> 3, kc = (cc & 7) * 8, n = n0 + nr;
                if (n < c.N) {
                    const float sc = (n >= c.slo && n < c.shi) ? c.scale : 1.f;
                    f32x4 a, b;
                    for (int e = 0; e < 4; ++e) { a[e] = tl[(kc + e) * 257 + nr] * sc; b[e] = tl[(kc + 4 + e) * 257 + nr] * sc; }
                    const int nd = c.ilv ? (n < DFF ? 256 * (n / 128) + n % 128 : 256 * ((n - DFF) / 128) + 128 + (n - DFF) % 128) : n;
                    *(bf16x8*)(c.dst + (size_t)nd * c.K + k0 + kc) = pack8(a, b);
                }
            }
        }
    }
    for (int i = gtid; i < (NNSA_PAD - NNSA) * D / 8; i += gn) *(bf16x8*)(p.Wnsa_in + (size_t)NNSA * D + (size_t)i * 8) = (bf16x8){0, 0, 0, 0, 0, 0, 0, 0};
    for (int i = gtid; i < 2 * 128 * 128; i += gn) { const int c = i >> 14, n = (i >> 7) & 127, k = i & 127; const float* w2 = c ? p.w_cv2 : p.w_ck2; p.Wc2[i] = n < 64 ? f2bf(w2[k * 64 + n]) : (bf16_t)0; }
    for (int i = gtid; i < 256 * D; i += gn) { const int r = i >> 10, k = i & 1023; float v = 0.f; if (r < BATCH) v = siluf(p.c_prompt[r * D + k]); else if (r < NBAT) v = siluf(p.c_sample[(r - BATCH) * D + k]); p.scb[i] = f2bf(v); }
    for (int i = gtid; i < NBAT * NCBS * 256 / 8; i += gn) { ((bf16x8*)p.kc)[i] = (bf16x8){0, 0, 0, 0, 0, 0, 0, 0}; ((bf16x8*)p.vcT)[i] = (bf16x8){0, 0, 0, 0, 0, 0, 0, 0}; }
    for (int i = gw; i < 256; i += nw) { const int c = i >> 7, n = i & 127; const float* pe = c ? p.pe_cv : p.pe_ck; const float* w1 = c ? p.w_cv1 : p.w_ck1; float s = 0.f;
#pragma unroll 8
        for (int k = lane; k < 2048; k += 64) s += pe[k] * w1[(size_t)k * 128 + n];
        s = wave_sum(s); if (lane == 0) p.cbias[i] = s; }
}

template <bool TWO>
DI void phase_normmod(const Params& p, bool from_input, const float* g1, int sh1, int sc1, bf16_t* dst1, const float* g2, int sh2, int sc2, bf16_t* dst2) {
    const int lane = threadIdx.x & 63, gw = blockIdx.x * 8 + (threadIdx.x >> 6), nw = gridDim.x * 8;
    for (int tok = gw; tok < TT; tok += nw) {
        const float* mrow = p.mod + (size_t)tok_batch(tok) * MODN;
        f32x4 v[4]; float ss = 0.f;
#pragma unroll
        for (int i = 0; i < 4; ++i) { v[i] = from_input ? *(const f32x4*)(x_in_row(p, tok) + i * 256 + lane * 4) : unpack4(*(const bf16x4*)(p.X + (size_t)tok * D + i * 256 + lane * 4)); ss += v[i].x * v[i].x + v[i].y * v[i].y + v[i].z * v[i].z + v[i].w * v[i].w; }
        ss = wave_sum(ss);
        const float rstd = 1.0f / sqrtf(ss * (1.0f / D) + 1e-6f);
#pragma unroll
        for (int i = 0; i < 4; ++i) {
            const int c = i * 256 + lane * 4;
            const f32x4 g = *(const f32x4*)(g1 + c), sh = *(const f32x4*)(mrow + sh1 + c), sc = *(const f32x4*)(mrow + sc1 + c);
            f32x4 o; for (int e = 0; e < 4; ++e) o[e] = v[i][e] * rstd * g[e] * (1.f + sc[e]) + sh[e];
            *(bf16x4*)(dst1 + (size_t)tok * D + c) = pack4(o);
            if (TWO) {
                const f32x4 gg = *(const f32x4*)(g2 + c), sh_ = *(const f32x4*)(mrow + sh2 + c), sc_ = *(const f32x4*)(mrow + sc2 + c);
                f32x4 o2; for (int e = 0; e < 4; ++e) o2[e] = v[i][e] * rstd * gg[e] * (1.f + sc_[e]) + sh_[e];
                *(bf16x4*)(dst2 + (size_t)tok * D + c) = pack4(o2);
            }
        }
    }
}
DI void phase_final_norm(const Params& p) {
    const int lane = threadIdx.x & 63, gw = blockIdx.x * 8 + (threadIdx.x >> 6), nw = gridDim.x * 8;
    for (int tok = gw; tok < TT; tok += nw) {
        float* yr = tok < TP ? p.y_prompt + (size_t)tok * D : p.y_sample + (size_t)(tok - TP) * D;
        f32x4 v[4]; float ss = 0.f;
#pragma unroll
        for (int i = 0; i < 4; ++i) { v[i] = unpack4(*(const bf16x4*)(p.X + (size_t)tok * D + i * 256 + lane * 4)); ss += v[i].x * v[i].x + v[i].y * v[i].y + v[i].z * v[i].z + v[i].w * v[i].w; }
        ss = wave_sum(ss);
        const float rstd = 1.0f / sqrtf(ss * (1.0f / D) + 1e-6f);
#pragma unroll
        for (int i = 0; i < 4; ++i) { const int c = i * 256 + lane * 4; const f32x4 g = *(const f32x4*)(p.g_final + c); f32x4 o; for (int e = 0; e < 4; ++e) o[e] = v[i][e] * rstd * g[e]; *(f32x4*)(yr + c) = o; }
    }
}

struct EpiAda {
    static constexpr bool WIDE8 = false;
    float* mod; const float *b_ada, *b_ada_kv;
    DI void operator()(int m, int n, f32x4 v) const {
        if (m >= NBAT) return;
        const float* b = n < 12 * D ? b_ada + n : b_ada_kv + (n - 12 * D);
        const f32x4 bv = *(const f32x4*)b;
        *(f32x4*)(mod + (size_t)m * MODN + n) = v + bv;
    }
};
DI float ret_gamma_log2(int h) {
    return h == 0 ? -0.045803689613124755f : h == 1 ? -0.022720076500083520f : h == 2 ? -0.011315313227834093f : -0.005646563141142062f;
}
#ifdef EMU
DI float exp2_fast(float x) { return exp2f(x); }
#else
DI float exp2_fast(float x) { return __builtin_amdgcn_exp2f(x); }
#endif
struct EpiRetIn {
    static constexpr bool WIDE8 = false;
    bf16_t *qb, *kb, *vb, *sgb, *kT, *vT;
    DI void operator()(int m, int n, f32x4 v) const {
        const int i = m < TP ? (m % SEQ) % CH : (m - TP) % DS;
        if (n < NQ) { const float f = exp2_fast(ret_gamma_log2(n >> 8) * (float)i); *(bf16x4*)(qb + (size_t)m * NQ + n) = pack4(v * f); }
        else if (n < 2 * NQ) {
            const int c = n - NQ, h = c >> 8; const float f = exp2_fast(-ret_gamma_log2(h) * (float)i); const f32x4 kv = v * f;
            *(bf16x4*)(kb + (size_t)m * NQ + c) = pack4(kv);
            if (m < TP) { const int b = m / SEQ, t = m % SEQ; for (int e = 0; e < 4; ++e) kT[((size_t)(b * HA + h) * DK + (c & 255) + e) * SEQ + t] = f2bf(kv[e]); }
        } else if (n < 2 * NQ + NV) {
            const int c = n - 2 * NQ;
            if (m >= TP) *(bf16x4*)(vb + (size_t)m * NV + c) = pack4(v);
            else { const int b = m / SEQ, t = m % SEQ; for (int e = 0; e < 4; ++e) vT[((size_t)b * NV + c + e) * SEQ + t] = f2bf(v[e]); }
        } else { const int c = n - 2 * NQ - NV; f32x4 s; for (int e = 0; e < 4; ++e) s[e] = silu_fast(v[e]); *(bf16x4*)(sgb + (size_t)m * NV + c) = pack4(s); }
    }
};
struct EpiResid {
    static constexpr bool WIDE8 = true;
    const Params* p; bool from_input; int gate_off;
    DI void operator()(int m, int n, f32x4 v) const {
        const f32x4 x = from_input ? *(const f32x4*)(x_in_row(*p, m) + n) : unpack4(*(const bf16x4*)(p->X + (size_t)m * D + n));
        const f32x4 g = *(const f32x4*)(p->mod + (size_t)tok_batch(m) * MODN + gate_off + n);
        *(bf16x4*)(p->X + (size_t)m * D + n) = pack4(x + g * v);
    }
    DI void wide(int m, int n, f32x4 v0, f32x4 v1) const {
        f32x4 x0, x1;
        if (from_input) { const float* xr = x_in_row(*p, m) + n; x0 = *(const f32x4*)xr; x1 = *(const f32x4*)(xr + 4); }
        else { const bf16x8 xb = *(const bf16x8*)(p->X + (size_t)m * D + n); for (int e = 0; e < 4; ++e) { x0[e] = bf2f((bf16_t)xb[e]); x1[e] = bf2f((bf16_t)xb[4 + e]); } }
        const float* gp = p->mod + (size_t)tok_batch(m) * MODN + gate_off + n;
        *(bf16x8*)(p->X + (size_t)m * D + n) = pack8(x0 + *(const f32x4*)gp * v0, x1 + *(const f32x4*)(gp + 4) * v1);
    }
};
struct EpiFfnConv {
    static constexpr bool PERM = true, AFTER_DRAIN = false;
    const Params* p; int l; int M;
    template <bool SAMPLE>
    __device__ __forceinline__ void body(const pg8::f32x4 (&acc)[2][2][4][2], const pg8::Unit& u, int wr, int wc, int fr, int fq) const {
        const Params& P = *p;
        const float* cw = P.conv_w + (size_t)l * 3 * F2; const float* cb = P.conv_b + (size_t)l * F2;
        const bool seq_end = SAMPLE ? true : (((u.pm + 1) * 256) % SEQ == 0);
#pragma unroll
        for (int n = 0; n < 2; ++n) {
            const int ca = u.pn * 128 + wc * 32 + 8 * fq + 4 * n;
            f32x4 w0[2], w1[2], w2[2], bb[2];
#pragma unroll
            for (int bj = 0; bj < 2; ++bj) { const int col = bj * DFF + ca; w0[bj] = *(const f32x4*)(cw + col); w1[bj] = *(const f32x4*)(cw + F2 + col); w2[bj] = *(const f32x4*)(cw + 2 * F2 + col); bb[bj] = *(const f32x4*)(cb + col); }
#pragma unroll
            for (int ai = 0; ai < 2; ++ai)
#pragma unroll
                for (int m = 0; m < 4; ++m) {
                    const int row = u.pm * 256 + ai * 128 + wr * 64 + 16 * m + fr;
                    const int t = SAMPLE ? (row - TP) % DS : 2;
                    const float* hist = (SAMPLE && row < M) ? P.state_conv + ((size_t)l * DB + (row - TP) / DS) * 2 * F2 : nullptr;
                    f32x4 z[2];
#pragma unroll
                    for (int bj = 0; bj < 2; ++bj) {
                        const f32x4 cur = acc[ai][bj][m][n], prv = acc[ai][bj][m > 0 ? m - 1 : 0][n];
                        f32x4 x1, x0;
#pragma unroll
                        for (int e = 0; e < 4; ++e) { x1[e] = dpp_shr<1>(cur[e], dpp_ror<1>(prv[e])); x0[e] = dpp_shr<2>(cur[e], dpp_ror<2>(prv[e])); }
                        if (SAMPLE) {
                            const int col = bj * DFF + ca;
                            if (t < 1) x1 = hist ? *(const f32x4*)(hist + F2 + col) : (f32x4){0.f, 0.f, 0.f, 0.f};
                            if (t < 2) x0 = hist ? *(const f32x4*)(hist + (size_t)t * F2 + col) : (f32x4){0.f, 0.f, 0.f, 0.f};
                        }
                        z[bj] = bb[bj] + w0[bj] * x0 + w1[bj] * x1 + w2[bj] * cur;
                    }
                    if (SAMPLE ? row < M : true) {
                        if (!(m == 0 && fr < 2)) {
                            f32x4 a0;
#pragma unroll
                            for (int e = 0; e < 4; ++e) a0[e] = silu_fast(z[1][e]) * z[0][e];
                            *(bf16x4*)(P.actf + (size_t)row * DFF + ca) = pack4(a0);
                        }
                        if (m == 0 || m == 3) {
                            const int sr = (m == 0 && fr < 2) ? fr : ((m == 3 && fr >= 14) ? fr - 12 : -1);
                            if (sr >= 0) {
#pragma unroll
                                for (int bj = 0; bj < 2; ++bj) *(bf16x4*)(P.uh + ((size_t)(row >> 6) * 4 + sr) * F2 + bj * DFF + ca) = pack4(acc[ai][bj][m][n]);
                            }
                        }
                        if (SAMPLE) {
                            if (t >= DS - 2) { float* cd = P.conv_sample + (size_t)l * DB * 2 * F2 + ((size_t)((row - TP) / DS) * 2 + (t - (DS - 2))) * F2;
#pragma unroll
                                for (int bj = 0; bj < 2; ++bj) *(f32x4*)(cd + bj * DFF + ca) = acc[ai][bj][m][n]; }
                        } else if (ai == 1 && m == 3) {
                            if (seq_end && wr == 1 && fr >= 14) { float* cd = P.conv_prompt + (size_t)l * BATCH * 2 * F2 + ((size_t)(row / SEQ) * 2 + (fr - 14)) * F2;
#pragma unroll
                                for (int bj = 0; bj < 2; ++bj) *(f32x4*)(cd + bj * DFF + ca) = acc[ai][bj][m][n]; }
                        }
                    }
                }
#ifndef EMU
            asm volatile("" ::: "memory");
#endif
        }
    }
    __device__ __forceinline__ void operator()(const pg8::f32x4 (&acc)[2][2][4][2], const pg8::Unit& u, int wr, int wc, int fr, int fq) const {
        if (u.pm * 256 >= TP) body<true>(acc, u, wr, wc, fr, fq); else body<false>(acc, u, wr, wc, fr, fq);
    }
};
DI void phase_conv_fix(const Params& p, int l) {
    const int gtid = blockIdx.x * 512 + threadIdx.x, gn = gridDim.x * 512;
    const float* cw = p.conv_w + (size_t)l * 3 * F2; const float* cb = p.conv_b + (size_t)l * F2;
    constexpr int NSEG = TT / 64, NI = NSEG * 2 * (DFF / 8);
    for (int idx = gtid; idx < NI; idx += gn) {
        const int c = (idx % (DFF / 8)) * 8, rk = idx / (DFF / 8), k = rk & 1, seg = rk >> 1, row = seg * 64 + k;
        const int t = row < TP ? row % SEQ : (row - TP) % DS;
        const float* hist = row < TP ? nullptr : p.state_conv + ((size_t)l * DB + (row - TP) / DS) * 2 * F2;
        float za[8], zg[8];
#pragma unroll
        for (int half = 0; half < 2; ++half) {
            const int col = half * DFF + c; float* z = half ? zg : za;
            const bf16x8 u2 = *(const bf16x8*)(p.uh + ((size_t)seg * 4 + k) * F2 + col);
            float x0[8], x1[8];
            if (t >= 1) { const bf16x8 v = k == 1 ? *(const bf16x8*)(p.uh + ((size_t)seg * 4 + 0) * F2 + col) : *(const bf16x8*)(p.uh + ((size_t)(seg - 1) * 4 + 3) * F2 + col); for (int e = 0; e < 8; ++e) x1[e] = bf2f((bf16_t)v[e]); }
            else { for (int e = 0; e < 8; ++e) x1[e] = hist ? hist[F2 + col + e] : 0.f; }
            if (t >= 2) { const bf16x8 v = k == 1 ? *(const bf16x8*)(p.uh + ((size_t)(seg - 1) * 4 + 3) * F2 + col) : *(const bf16x8*)(p.uh + ((size_t)(seg - 1) * 4 + 2) * F2 + col); for (int e = 0; e < 8; ++e) x0[e] = bf2f((bf16_t)v[e]); }
            else { for (int e = 0; e < 8; ++e) x0[e] = hist ? hist[(size_t)t * F2 + col + e] : 0.f; }
            for (int e = 0; e < 8; ++e) z[e] = cb[col + e] + cw[col + e] * x0[e] + cw[F2 + col + e] * x1[e] + cw[2 * F2 + col + e] * bf2f((bf16_t)u2[e]);
        }
        f32x4 a, b2; for (int e = 0; e < 4; ++e) { a[e] = siluf(zg[e]) * za[e]; b2[e] = siluf(zg[4 + e]) * za[4 + e]; }
        *(bf16x8*)(p.actf + (size_t)row * DFF + c) = pack8(a, b2);
    }
}
struct EpiKv {
    static constexpr bool WIDE8 = false;
    const Params* p;
    DI void operator()(int m, int n, f32x4 v) const {
        const Params& P = *p;
        if (m < TP) {
            const int b = m / SEQ, t = m % SEQ;
            if ((n >= 512 && n < 768) || (n >= 1024 && n < 1280)) *(bf16x4*)(P.kvb + (size_t)m * NKV + n) = pack4(v);
            if (n < 512) *(bf16x4*)(P.Acmp + ((size_t)(n >> 8) * CROWS_PAD + (size_t)(b * NPC_P + (t >> 4)) * 4 + ((n >> 6) & 3)) * 1024 + (t & 15) * 64 + (n & 63)) = pack4(v);
            if (n < 1024) *(f32x4*)(P.kv_prompt + (size_t)m * 1024 + n) = v;
            else if (t >= SEQ - WINP) *(f32x4*)(P.win_prompt + ((size_t)b * WINP + (t - (SEQ - WINP))) * 512 + (n - 1024)) = v;
            if (n >= 768 && n < 1024) { for (int e = 0; e < 4; ++e) P.vTs[((size_t)b * 256 + (n - 768) + e) * SEQ + t] = f2bf(v[e]); }
            if (n >= 1280) { for (int e = 0; e < 4; ++e) P.vTw[((size_t)b * 256 + (n - 1280) + e) * SEQ + t] = f2bf(v[e]); }
        } else {
            const int b = (m - TP) / DS, t = (m - TP) % DS;
            if (n < 1024) *(f32x4*)(P.kv_sample + (size_t)(m - TP) * 1024 + n) = v;
            else *(f32x4*)(P.win_sample + ((size_t)b * WINS + (WINS - DS + t)) * 512 + (n - 1024)) = v;
        }
    }
};
struct EpiNsaIn {
    static constexpr bool WIDE8 = false;
    bf16_t* qb; float* gates;
    DI void operator()(int m, int n, f32x4 v) const {
        if (n < HB * DH) *(bf16x4*)(qb + (size_t)m * (HB * DH) + n) = pack4(v);
        else if (n < NNSA) { f32x4 s; for (int e = 0; e < 4; ++e) s[e] = sigmoid_fast(v[e]); *(f32x4*)(gates + (size_t)m * 48 + (n - HB * DH)) = s; }
    }
};
struct LoadCmp {
    const Params* p; int c;
    DI bf16x8 operator()(int r, int k0) const {
        const Params& P = *p; const int s = k0 >> 6, d0 = k0 & 63;
        if (r < CROWS_P) { const int g = r & 3, j = (r >> 2) % NPC_P, b = (r >> 2) / NPC_P; return *(const bf16x8*)(P.kvb + (size_t)(b * SEQ + 16 * j + s) * NKV + c * 256 + g * 64 + d0); }
        const int rr = r - CROWS_P, g = rr & 3, j = (rr >> 2) % NPC_S, b = (rr >> 2) / NPC_S, pos = 16 * j + s;
        const int page = P.page_table[b * NPAGES + (pos >> 7)];
        const float* src = P.cache_kv + ((size_t)page * PAGE + (pos & 127)) * 1024 + c * 256 + g * 64 + d0;
        return pack8(*(const f32x4*)src, *(const f32x4*)(src + 4));
    }
};
struct EpiZ1 {
    static constexpr bool WIDE8 = true; bf16_t* Z1; DI void operator()(int m, int n, f32x4 v) const { *(bf16x4*)(Z1 + (size_t)m * 256 + n) = pack4(v); }
    DI void wide(int m, int n, f32x4 v0, f32x4 v1) const { *(bf16x8*)(Z1 + (size_t)m * 256 + n) = pack8(v0, v1); } };
struct LoadCmp2 {
    const bf16_t* Z1; const float* bias;
    DI bf16x8 operator()(int r, int k0) const {
        const int npc = r < CROWS_P ? NPC_P : NPC_S; const int i = ((r < CROWS_P ? r : r - CROWS_P) >> 2) % npc;
        const int r2 = (i + 1 < npc) ? r + 4 : r;
        const bf16x8 z0 = *(const bf16x8*)(Z1 + (size_t)r * 256 + k0), z1 = *(const bf16x8*)(Z1 + (size_t)r2 * 256 + 128 + k0);
        const f32x4 c0 = *(const f32x4*)(bias + k0), c1 = *(const f32x4*)(bias + k0 + 4);
        f32x4 a, b;
        for (int e = 0; e < 4; ++e) { a[e] = siluf(bf2f((bf16_t)z0[e]) + bf2f((bf16_t)z1[e]) + c0[e]); b[e] = siluf(bf2f((bf16_t)z0[4 + e]) + bf2f((bf16_t)z1[4 + e]) + c1[e]); }
        return pack8(a, b);
    }
};
struct EpiCmp2 {
    static constexpr bool WIDE8 = false;
    bf16_t* kc; bf16_t* vcT; int c;
    DI void operator()(int m, int n, f32x4 v) const {
        if (n >= 64) return;
        int bb, i, g;
        if (m < CROWS_P) { g = m & 3; i = (m >> 2) % NPC_P; bb = (m >> 2) / NPC_P; if (i >= NCB_P) v = (f32x4){0.f, 0.f, 0.f, 0.f}; }
        else { const int rr = m - CROWS_P; g = rr & 3; i = (rr >> 2) % NPC_S; bb = BATCH + (rr >> 2) / NPC_S; if (i >= NCB_S) v = (f32x4){0.f, 0.f, 0.f, 0.f}; }
        if (c == 0) *(bf16x4*)(kc + ((size_t)(bb * NCBS + i) * 4 + g) * 64 + n) = pack4(v);
        else { for (int e = 0; e < 4; ++e) vcT[((size_t)(bb * 4 + g) * 64 + n + e) * NCBS + i] = f2bf(v[e]); }
    }
};

DI void phase_ret_prompt(const Params& p, char* lds) {
    constexpr int STP = 264, KPP = 264, VTP = 136;
    bf16_t* ST = (bf16_t*)lds;
    bf16_t* Kp = ST + 64 * STP;
    bf16_t* VTs = Kp + 128 * KPP;
    const int tid = threadIdx.x, lane = tid & 63, w = UNIFORM(tid >> 6), l15 = lane & 15, q = lane >> 4;
    for (int item = blockIdx.x; item < BATCH * HA * 8; item += gridDim.x) {
        const int es = item & 7, h = (item >> 3) & 3, b = item >> 5;
        const float lg2 = ret_gamma_log2(h), gam = exp2f(lg2), gam127 = exp2f(lg2 * 127.f);
        f32x4 S[2][4];
#pragma unroll
        for (int i = 0; i < 2; ++i)
#pragma unroll
            for (int j = 0; j < 4; ++j) S[i][j] = (f32x4){0.f, 0.f, 0.f, 0.f};
        __syncthreads();
        for (int i = tid; i < 64 * STP / 8; i += 512) ((bf16x8*)ST)[i] = (bf16x8){0, 0, 0, 0, 0, 0, 0, 0};
        const bf16_t* vTb = p.vT + ((size_t)b * NV + h * DV + es * 64) * SEQ;
        const bf16_t* kTb = p.kT + ((size_t)(b * HA + h) * DK) * SEQ;
        constexpr int NC = SEQ / CH;
        bf16x8 rk[8], rv[2], qf[8], ka[2][4];
        auto load_stage = [&](int cn) { const int t0n = cn * CH; const unsigned tbn = (unsigned)(b * SEQ + t0n);
#pragma unroll
            for (int i = 0; i < 8; ++i) { const int cc = tid + 512 * i; rk[i] = *(const bf16x8*)(p.kb + ((tbn + (unsigned)(cc >> 5)) * NQ + (unsigned)(h * DK + (cc & 31) * 8))); }
#pragma unroll
            for (int i = 0; i < 2; ++i) { const int cc = tid + 512 * i; rv[i] = *(const bf16x8*)(vTb + (unsigned)((cc >> 4) * SEQ + t0n + (cc & 15) * 8)); } };
        auto load_q = [&](int cn) { const unsigned tbn = (unsigned)(b * SEQ + cn * CH);
#pragma unroll
            for (int ks = 0; ks < 8; ++ks) qf[ks] = *(const bf16x8*)(p.qb + ((tbn + (unsigned)(16 * w + l15)) * NQ + (unsigned)(h * DK + ks * 32 + q * 8))); };
        auto load_ka = [&](int cn) { const int t0n = cn * CH;
#pragma unroll
            for (int i = 0; i < 2; ++i)
#pragma unroll
                for (int ks2 = 0; ks2 < 4; ++ks2) ka[i][ks2] = *(const bf16x8*)(kTb + (unsigned)((32 * w + 16 * i + l15) * SEQ + t0n + 32 * ks2 + 8 * q)); };
        load_stage(0); load_q(0); load_ka(0);
#pragma unroll 1
        for (int c = 0; c < NC; ++c) {
            const int t0 = c * CH; const unsigned tokbase = (unsigned)(b * SEQ + t0);
            const int cn = c + 1 < NC ? c + 1 : c;
#pragma unroll
            for (int i = 0; i < 8; ++i) { const int cc = tid + 512 * i; *(bf16x8*)(Kp + (cc >> 5) * KPP + (cc & 31) * 8) = rk[i]; }
#pragma unroll
            for (int i = 0; i < 2; ++i) { const int cc = tid + 512 * i; *(bf16x8*)(VTs + (cc >> 4) * VTP + (cc & 15) * 8) = rv[i]; }
            __syncthreads();
            load_stage(cn);
            f32x4 O[4];
#pragma unroll
            for (int ef = 0; ef < 4; ++ef) O[ef] = (f32x4){0.f, 0.f, 0.f, 0.f};
#pragma unroll
            for (int ks = 0; ks < 8; ++ks)
#pragma unroll
                for (int ef = 0; ef < 4; ++ef) { const bf16x8 a = *(const bf16x8*)(ST + (16 * ef + l15) * STP + ks * 32 + q * 8); O[ef] = MFMA16(a, qf[ks], O[ef]); }
#pragma unroll 1
            for (int jt2 = 0; jt2 <= (w >> 1); ++jt2) {
                f32x4 pt0 = (f32x4){0.f, 0.f, 0.f, 0.f}, pt1 = pt0;
#pragma unroll
                for (int ks = 0; ks < 8; ++ks) {
                    const bf16x8 k0 = *(const bf16x8*)(Kp + (32 * jt2 + l15) * KPP + ks * 32 + q * 8);
                    const bf16x8 k1 = *(const bf16x8*)(Kp + (32 * jt2 + 16 + l15) * KPP + ks * 32 + q * 8);
                    pt0 = MFMA16(k0, qf[ks], pt0); pt1 = MFMA16(k1, qf[ks], pt1);
                }
                const int i = 16 * w + l15, j0 = 32 * jt2 + 4 * q;
#pragma unroll
                for (int r = 0; r < 4; ++r) { if (j0 + r > i) pt0[r] = 0.f; if (j0 + 16 + r > i) pt1[r] = 0.f; }
                const bf16x8 pf = pack8(pt0, pt1);
#pragma unroll
                for (int ef = 0; ef < 4; ++ef) {
                    const bf16_t* vp = VTs + (16 * ef + l15) * VTP + 32 * jt2 + 4 * q;
                    O[ef] = MFMA16(cat4(*(const bf16x4*)vp, *(const bf16x4*)(vp + 16)), pf, O[ef]);
                }
            }
            {
                float ss = 0.f;
#pragma unroll
                for (int ef = 0; ef < 4; ++ef) { *(bf16x4*)(p.obuf + ((tokbase + (unsigned)(16 * w + l15)) * NV + (unsigned)(h * DV + es * 64 + 16 * ef + 4 * q))) = pack4(O[ef]); for (int r = 0; r < 4; ++r) ss += O[ef][r] * O[ef][r]; }
                ss += __shfl_xor(ss, 16); ss += __shfl_xor(ss, 32);
                if (q == 0) p.ssq[(tokbase + (unsigned)(16 * w + l15)) * 32 + h * 8 + es] = ss;
            }
            load_q(cn);
#pragma unroll
            for (int i = 0; i < 2; ++i)
#pragma unroll
                for (int j = 0; j < 4; ++j) S[i][j] = S[i][j] * gam;
#pragma unroll
            for (int ks2 = 0; ks2 < 4; ++ks2) {
#pragma unroll
                for (int j = 0; j < 4; ++j) {
                    const bf16x8 vb_ = *(const bf16x8*)(VTs + (16 * j + l15) * VTP + 32 * ks2 + 8 * q);
#pragma unroll
                    for (int i = 0; i < 2; ++i) S[i][j] = MFMA16(ka[i][ks2], vb_, S[i][j]);
                }
            }
            load_ka(cn);
#pragma unroll
            for (int i = 0; i < 2; ++i)
#pragma unroll
                for (int j = 0; j < 4; ++j) S[i][j] = S[i][j] * gam127;
            __syncthreads();
#pragma unroll
            for (int i = 0; i < 2; ++i)
#pragma unroll
                for (int j = 0; j < 4; ++j) *(bf16x4*)(ST + (16 * j + l15) * STP + 32 * w + 16 * i + 4 * q) = pack4(S[i][j] * gam);
        }
        float* so = p.ret_prompt + ((size_t)(b * HA + h) * DK) * DV + es * 64;
#pragma unroll
        for (int i = 0; i < 2; ++i)
#pragma unroll
            for (int j = 0; j < 4; ++j)
#pragma unroll
                for (int r = 0; r < 4; ++r) so[(size_t)(32 * w + 16 * i + 4 * q + r) * DV + 16 * j + l15] = S[i][j][r];
    }
}
DI void phase_ret_sample(const Params& p, char* lds) {
    float* Lq = (float*)lds; float* Lk = Lq + 2048; float* LP = Lk + 2048; float* Lo = LP + 64;
    const int tid = threadIdx.x, lane = tid & 63, w = tid >> 6;
    for (int item = blockIdx.x; item < DB * HA; item += gridDim.x) {
        const int b = item >> 2, h = item & 3; const size_t tok0 = (size_t)TP + b * DS;
        const float lg2 = ret_gamma_log2(h), gam = exp2f(lg2), g7 = exp2f(lg2 * 7.f), g8 = exp2f(lg2 * 8.f);
        __syncthreads();
        for (int i = tid; i < 2048; i += 512) { const int t = i >> 8, d = i & 255; Lq[i] = bf2f(p.qb[(tok0 + t) * NQ + h * DK + d]); Lk[i] = bf2f(p.kb[(tok0 + t) * NQ + h * DK + d]); }
        __syncthreads();
        if (tid < 64) { const int i = tid >> 3, j = tid & 7; float s = 0.f; if (j <= i) for (int d = 0; d < DK; ++d) s += Lq[i * 256 + d] * Lk[j * 256 + d]; LP[tid] = s; }
        const int dq = tid >> 7, e0 = (tid & 127) * 4;
        f32x4 vv[8], oacc[8];
#pragma unroll
        for (int j = 0; j < 8; ++j) { const bf16x4 t = *(const bf16x4*)(p.vb + (tok0 + j) * NV + h * DV + e0); for (int e = 0; e < 4; ++e) vv[j][e] = bf2f((bf16_t)t[e]); oacc[j] = (f32x4){0.f, 0.f, 0.f, 0.f}; }
        const float* S0 = p.state_ret + ((size_t)(b * HA + h) * DK) * DV; float* S1 = p.ret_sample + ((size_t)(b * HA + h) * DK) * DV;
        {
            f32x4 sv[2][4];
#pragma unroll
            for (int u = 0; u < 4; ++u) sv[0][u] = *(const f32x4*)(S0 + (size_t)(dq + 4 * u) * DV + e0);
#pragma unroll 1
            for (int dd = 0; dd < 64; dd += 8) {
#pragma unroll
                for (int half = 0; half < 2; ++half) {
                    const int dn = dd + 4 * half + 4;
                    if (dn < 64) {
#pragma unroll
                        for (int u = 0; u < 4; ++u) sv[half ^ 1][u] = *(const f32x4*)(S0 + (size_t)(dq + 4 * (dn + u)) * DV + e0);
                    }
#pragma unroll
                    for (int u = 0; u < 4; ++u) {
                        const int d = dq + 4 * (dd + 4 * half + u);
                        f32x4 upd = (f32x4){0.f, 0.f, 0.f, 0.f};
#pragma unroll
                        for (int j = 0; j < 8; ++j) { upd += vv[j] * Lk[j * 256 + d]; oacc[j] += sv[half][u] * Lq[j * 256 + d]; }
                        *(f32x4*)(S1 + (size_t)d * DV + e0) = sv[half][u] * g8 + upd * g7;
                    }
                }
            }
        }
#pragma unroll
        for (int i = 0; i < 8; ++i) *(f32x4*)(Lo + (dq * 8 + i) * 512 + e0) = oacc[i];
        __syncthreads();
        {
            const int i = w, e8 = lane * 8; float o[8]; float ss = 0.f;
#pragma unroll
            for (int e = 0; e < 8; ++e) o[e] = gam * (Lo[(0 * 8 + i) * 512 + e8 + e] + Lo[(1 * 8 + i) * 512 + e8 + e] + Lo[(2 * 8 + i) * 512 + e8 + e] + Lo[(3 * 8 + i) * 512 + e8 + e]);
            for (int j = 0; j <= i; ++j) { const float pj = LP[i * 8 + j]; const bf16x8 t = *(const bf16x8*)(p.vb + (tok0 + j) * NV + h * DV + e8); for (int e = 0; e < 8; ++e) o[e] += pj * bf2f((bf16_t)t[e]); }
            f32x4 a, c; for (int e = 0; e < 4; ++e) { a[e] = o[e]; c[e] = o[4 + e]; ss += o[e] * o[e] + o[4 + e] * o[4 + e]; }
            *(bf16x8*)(p.obuf + (tok0 + i) * NV + h * DV + e8) = pack8(a, c);
            ss = wave_sum(ss);
            if (lane < 8) p.ssq[(tok0 + i) * 32 + h * 8 + lane] = lane == 0 ? ss : 0.f;
        }
    }
}
DI void phase_ret_act(const Params& p) {
    const int gtid = blockIdx.x * 512 + threadIdx.x, gn = gridDim.x * 512;
    constexpr int NI = TT * (NV / 8);
    for (int i0 = gtid; i0 < NI; i0 += 4 * gn) {
        bf16x8 o[4], g[4]; float s[4];
#pragma unroll
        for (int u = 0; u < 4; ++u) { const int idx = i0 + u * gn; if (idx < NI) { const int tok = idx / (NV / 8), c8 = (idx % (NV / 8)) * 8, h = c8 / DV;
            o[u] = *(const bf16x8*)(p.obuf + (size_t)tok * NV + c8); g[u] = *(const bf16x8*)(p.sgb + (size_t)tok * NV + c8);
            const f32x4 s0 = *(const f32x4*)(p.ssq + (size_t)tok * 32 + h * 8), s1 = *(const f32x4*)(p.ssq + (size_t)tok * 32 + h * 8 + 4); s[u] = s0.x + s0.y + s0.z + s0.w + s1.x + s1.y + s1.z + s1.w; } }
#pragma unroll
        for (int u = 0; u < 4; ++u) { const int idx = i0 + u * gn; if (idx < NI) { const int tok = idx / (NV / 8), c8 = (idx % (NV / 8)) * 8;
            const float rstd = 1.0f / sqrtf(s[u] * (1.0f / DV) + 1e-6f);
            f32x4 a, c; for (int e = 0; e < 4; ++e) { a[e] = bf2f((bf16_t)o[u][e]) * rstd * bf2f((bf16_t)g[u][e]); c[e] = bf2f((bf16_t)o[u][4 + e]) * rstd * bf2f((bf16_t)g[u][4 + e]); }
            *(bf16x8*)(p.actr + (size_t)tok * NV + c8) = pack8(a, c); } }
    }
}
DI void phase_conv_act(const Params& p, int l) {
    const int gtid = blockIdx.x * 512 + threadIdx.x, gn = gridDim.x * 512;
    const float* cw = p.conv_w + (size_t)l * 3 * F2; const float* cb = p.conv_b + (size_t)l * F2;
    constexpr int NI = TT * (DFF / 8);
    for (int i0 = gtid; i0 < NI; i0 += 2 * gn) {
        bf16x8 ub[2][2][3];
#pragma unroll
        for (int u = 0; u < 2; ++u) { const int idx = i0 + u * gn; if (idx < NI) { const int tok = idx / (DFF / 8), c = (idx % (DFF / 8)) * 8; const int t = tok < TP ? tok % SEQ : (tok - TP) % DS;
#pragma unroll
            for (int half = 0; half < 2; ++half) { const int col = half * DFF + c;
                ub[u][half][2] = *(const bf16x8*)(p.u + (size_t)tok * F2 + col);
                ub[u][half][1] = *(const bf16x8*)(p.u + (size_t)(t >= 1 ? tok - 1 : tok) * F2 + col);
                ub[u][half][0] = *(const bf16x8*)(p.u + (size_t)(t >= 2 ? tok - 2 : tok) * F2 + col); } } }
#pragma unroll
        for (int u = 0; u < 2; ++u) { const int idx = i0 + u * gn; if (idx < NI) { const int tok = idx / (DFF / 8), c = (idx % (DFF / 8)) * 8; const int t = tok < TP ? tok % SEQ : (tok - TP) % DS;
            const float* hist = tok < TP ? nullptr : p.state_conv + ((size_t)l * DB + (tok - TP) / DS) * 2 * F2;
            float za[8], zg[8];
#pragma unroll
            for (int half = 0; half < 2; ++half) {
                const int col = half * DFF + c; float* z = half ? zg : za;
                float x0[8], x1[8];
                if (t >= 1) { for (int e = 0; e < 8; ++e) x1[e] = bf2f((bf16_t)ub[u][half][1][e]); } else { for (int e = 0; e < 8; ++e) x1[e] = hist ? hist[F2 + col + e] : 0.f; }
                if (t >= 2) { for (int e = 0; e < 8; ++e) x0[e] = bf2f((bf16_t)ub[u][half][0][e]); } else { for (int e = 0; e < 8; ++e) x0[e] = hist ? hist[(size_t)t * F2 + col + e] : 0.f; }
                for (int e = 0; e < 8; ++e) z[e] = cb[col + e] + cw[col + e] * x0[e] + cw[F2 + col + e] * x1[e] + cw[2 * F2 + col + e] * bf2f((bf16_t)ub[u][half][2][e]);
            }
            f32x4 a, b2; for (int e = 0; e < 4; ++e) { a[e] = siluf(zg[e]) * za[e]; b2[e] = siluf(zg[4 + e]) * za[4 + e]; }
            *(bf16x8*)(p.actf + (size_t)tok * DFF + c) = pack8(a, b2); } }
    }
}

constexpr float NEG = -1.0e30f;
DI float alibi_slope(int head) { return LOG2E * exp2f(-0.5f * (float)(head + 1)); }
constexpr int AKP = 72;
DI f32x4 cmp_tile_lds(const bf16_t* Kc, int kt, int t, int lane, bf16x8 q0, bf16x8 q1, float slope_h) {
    const int l15 = lane & 15, q = lane >> 4;
    const bf16_t* kp = Kc + (16 * kt + l15) * AKP + q * 8;
    f32x4 acc = (f32x4){0.f, 0.f, 0.f, 0.f};
    acc = MFMA16(*(const bf16x8*)kp, q0, acc); acc = MFMA16(*(const bf16x8*)(kp + 32), q1, acc);
#pragma unroll
    for (int r = 0; r < 4; ++r) { const int n = 16 * kt + 4 * q + r, cend = 16 * n + 31; acc[r] = (n < NCB_P && cend <= t) ? acc[r] - slope_h * (float)(t - cend) : NEG; }
    return acc;
}
template <int MODE>
DI void attn_tile2(bool FULL, const bf16_t* Kt, const bf16_t* Vt, int jblk, int t, int lane, const bf16x8 (&qf)[2][2], const float (&slope)[2], unsigned selmask,
                   float (&m)[2], float (&l)[2], f32x4 (&O)[2][4]) {
    const int l15 = lane & 15, q = lane >> 4;
    const bool tok_ok = MODE == 0 ? (((selmask >> jblk) & 1u) != 0u) : true;
    {
        constexpr int hp = 0;
        f32x4 sT[2][4];
#pragma unroll
        for (int kt = 0; kt < 4; ++kt) {
            const bf16_t* kp = Kt + (16 * kt + l15) * AKP + q * 8;
            const bf16x8 k0 = *(const bf16x8*)kp, k1 = *(const bf16x8*)(kp + 32);
#pragma unroll
            for (int hh = 0; hh < 2; ++hh) { f32x4 acc = (f32x4){0.f, 0.f, 0.f, 0.f}; acc = MFMA16(k0, qf[2 * hp + hh][0], acc); acc = MFMA16(k1, qf[2 * hp + hh][1], acc); sT[hh][kt] = acc; }
        }
#pragma unroll
        for (int hh = 0; hh < 2; ++hh) {
            const int h4 = 2 * hp + hh;
            float mx = NEG;
            {
                const int tdiff = t - 64 * jblk - 4 * q;
                const float base = -slope[h4] * (float)tdiff;
                if (FULL) {
#pragma unroll
                    for (int kt = 0; kt < 4; ++kt)
#pragma unroll
                        for (int r = 0; r < 4; ++r) { const float sv = (sT[hh][kt][r] + base) + slope[h4] * (float)(16 * kt + r); sT[hh][kt][r] = sv; mx = fmaxf(mx, sv); }
                } else {
#pragma unroll
                    for (int kt = 0; kt < 4; ++kt)
#pragma unroll
                        for (int r = 0; r < 4; ++r) {
                            float sv = (sT[hh][kt][r] + base) + slope[h4] * (float)(16 * kt + r);
                            const bool valid = tok_ok && (16 * kt + r) <= tdiff && (MODE == 0 || tdiff - (16 * kt + r) <= WINDOW); sv = valid ? sv : NEG;
                            sT[hh][kt][r] = sv; mx = fmaxf(mx, sv);
                        }
                }
            }
            mx = fmaxf(mx, __shfl_xor(mx, 16)); mx = fmaxf(mx, __shfl_xor(mx, 32));
            const float mnew = fmaxf(m[h4], mx), alpha = exp2_fast(m[h4] - mnew);
            float psum = 0.f;
            if (FULL) {
#pragma unroll
                for (int kt = 0; kt < 4; ++kt)
#pragma unroll
                    for (int r = 0; r < 4; ++r) { const float pe = exp2_fast(sT[hh][kt][r] - mnew); sT[hh][kt][r] = pe; psum += pe; }
            } else {
#pragma unroll
                for (int kt = 0; kt < 4; ++kt)
#pragma unroll
                    for (int r = 0; r < 4; ++r) { const float pe = sT[hh][kt][r] > 0.5f * NEG ? exp2_fast(sT[hh][kt][r] - mnew) : 0.f; sT[hh][kt][r] = pe; psum += pe; }
            }
            l[h4] = l[h4] * alpha + psum; m[h4] = mnew;
#pragma unroll
            for (int df = 0; df < 4; ++df) O[h4][df] = O[h4][df] * alpha;
        }
#pragma unroll
        for (int ks2 = 0; ks2 < 2; ++ks2) {
            const bf16x8 pf0 = pack8(sT[0][2 * ks2], sT[0][2 * ks2 + 1]), pf1 = pack8(sT[1][2 * ks2], sT[1][2 * ks2 + 1]);
#pragma unroll
            for (int df = 0; df < 4; ++df) {
                const bf16_t* vp = Vt + (16 * df + l15) * AKP + 32 * ks2 + 4 * q;
                const bf16x8 vf = cat4(*(const bf16x4*)vp, *(const bf16x4*)(vp + 16));
                O[2 * hp][df] = MFMA16(vf, pf0, O[2 * hp][df]); O[2 * hp + 1][df] = MFMA16(vf, pf1, O[2 * hp + 1][df]);
            }
        }
    }
}
template <int MODE>
DI void attn_run_blocks(const Params& p, int b, int g, unsigned list, unsigned wave_need, unsigned wave_full, int t, int lane, int tid, const bf16x8 (&qf)[2][2], const float (&slope)[2], unsigned selmask,
                        float (&m)[2], float (&l)[2], f32x4 (&O)[2][4], bf16_t* Kt, bf16_t* Vt) {
    if (list == 0u) return;
    const bf16_t* kg = p.kvb + (size_t)b * SEQ * NKV + (MODE == 0 ? 512 : 1024) + g * 64 + (unsigned)((tid >> 3) * NKV + (tid & 7) * 8);
    const bf16_t* vg = (MODE == 0 ? p.vTs : p.vTw) + ((size_t)b * 256 + g * 64) * SEQ + (unsigned)((tid >> 3) * SEQ + (tid & 7) * 8);
    const int so = (tid >> 3) * AKP + (tid & 7) * 8;
    unsigned rem = list; int jb = __builtin_ctz(rem); rem &= rem - 1u;
    bf16x8 rk = *(const bf16x8*)(kg + (unsigned)(64 * jb * NKV)), rv = *(const bf16x8*)(vg + 64 * jb);
    int buf = 0;
    __syncthreads();
    *(bf16x8*)(Kt + so) = rk; *(bf16x8*)(Vt + so) = rv;
    __syncthreads();
    for (;;) {
        const int jn = rem ? __builtin_ctz(rem) : -1;
        if (jn >= 0) { rk = *(const bf16x8*)(kg + (unsigned)(64 * jn * NKV)); rv = *(const bf16x8*)(vg + 64 * jn); }
        if ((wave_need >> jb) & 1u) {
            attn_tile2<MODE>(((wave_full >> jb) & 1u) != 0u, Kt + buf * 64 * AKP, Vt + buf * 64 * AKP, jb, t, lane, qf, slope, selmask, m, l, O);
        }
        if (jn < 0) break;
        buf ^= 1;
        *(bf16x8*)(Kt + buf * 64 * AKP + so) = rk; *(bf16x8*)(Vt + buf * 64 * AKP + so) = rv;
        __syncthreads();
        jb = jn; rem &= rem - 1u;
    }
}
DI void phase_attn_prompt2(const Params& p, char* lds) {
    const int tid = threadIdx.x, lane0 = tid & 63, w = UNIFORM(tid >> 6);
    bf16_t* Kc = (bf16_t*)lds;
    bf16_t* VcT = Kc + 128 * AKP;
    unsigned* Lmask = (unsigned*)(VcT + 64 * 136);
    char* dyn = (char*)(Lmask + 16);
    bf16_t* Kt = (bf16_t*)dyn;
    bf16_t* Vt = Kt + 2 * 64 * AKP;
    float* pkey = (float*)dyn + (size_t)w * (16 * 128 + 16 * 32);
    float* impL = pkey + 16 * 128;
    constexpr int NT = SEQ / 128, NBG = BATCH * GB, NIT = NBG * NT;
    for (int it = blockIdx.x; it < NIT; it += gridDim.x) {
        const int r = it / NBG, bg = it % NBG, tile = r < NT / 2 ? NT - 1 - r : r - NT / 2;
        const int b = bg / GB, g = bg % GB, T0 = tile * 128;
        int lane = lane0; OPAQUE(lane);
        const int l15 = lane & 15, q = lane >> 4;
        const int t0 = T0 + 16 * w, t = t0 + l15; const unsigned tok = (unsigned)(b * SEQ + t);
        const float* gt = p.gates + (tok * 48u + (unsigned)(g * 12));
        __syncthreads();
        {
            const int n = tid >> 2, c = (tid & 3) * 16;
            const bf16_t* src = p.kc + ((size_t)(b * NCBS + n) * 4 + g) * 64 + c;
            *(bf16x8*)(Kc + n * AKP + c) = *(const bf16x8*)src; *(bf16x8*)(Kc + n * AKP + c + 8) = *(const bf16x8*)(src + 8);
            const int d = tid >> 3, c2 = (tid & 7) * 16;
            const bf16_t* src2 = p.vcT + ((size_t)(b * 4 + g) * 64 + d) * NCBS + c2;
            *(bf16x8*)(VcT + d * 136 + c2) = *(const bf16x8*)src2; *(bf16x8*)(VcT + d * 136 + c2 + 8) = *(const bf16x8*)(src2 + 8);
        }
        __syncthreads();
        int ncv = (t0 + 15 >= 31) ? (t0 + 15 - 31) / 16 + 1 : 0; ncv = ncv < NCB_P ? ncv : NCB_P;
        const int nkt = (ncv + 15) >> 4;
        bf16x8 qf[4][2]; float slope[4];
#pragma unroll
        for (int hh = 0; hh < 4; ++hh) { slope[hh] = alibi_slope(g * 4 + hh); for (int ks = 0; ks < 2; ++ks) qf[hh][ks] = *(const bf16x8*)(p.qb + (tok * 1024u + (unsigned)((g * 4 + hh) * 64 + ks * 32 + q * 8))); }
        float mC[4], ilC[4];
#pragma unroll
        for (int kt = 0; kt < 8; ++kt) *(f32x4*)(pkey + l15 * 128 + 16 * kt + 4 * q) = (f32x4){0.f, 0.f, 0.f, 0.f};
#pragma unroll
        for (int hh = 0; hh < 4; ++hh) {
            float mx = NEG, sm = 0.f;
#pragma unroll 1
            for (int kt = 0; kt < nkt; ++kt) {
                const f32x4 sv = cmp_tile_lds(Kc, kt, t, lane, qf[hh][0], qf[hh][1], slope[hh]);
                const float tm = fmaxf(fmaxf(sv[0], sv[1]), fmaxf(sv[2], sv[3])), mn = fmaxf(mx, tm);
                float e = 0.f;
#pragma unroll
                for (int rr = 0; rr < 4; ++rr) e += sv[rr] > 0.5f * NEG ? exp2_fast(sv[rr] - mn) : 0.f;
                sm = sm * exp2_fast(mx - mn) + e; mx = mn;
            }
            float ma = fmaxf(mx, __shfl_xor(mx, 16)); ma = fmaxf(ma, __shfl_xor(ma, 32));
            sm *= exp2_fast(mx - ma); sm += __shfl_xor(sm, 16); sm += __shfl_xor(sm, 32);
            mC[hh] = ma; ilC[hh] = 1.0f / fmaxf(sm, 1e-30f);
#pragma unroll 1
            for (int kt = 0; kt < nkt; ++kt) {
                const f32x4 sv = cmp_tile_lds(Kc, kt, t, lane, qf[hh][0], qf[hh][1], slope[hh]);
                f32x4 pv;
#pragma unroll
                for (int rr = 0; rr < 4; ++rr) pv[rr] = sv[rr] > 0.5f * NEG ? exp2_fast(sv[rr] - ma) * ilC[hh] : 0.f;
                float* pk = pkey + l15 * 128 + 16 * kt + 4 * q;
                *(f32x4*)pk = *(const f32x4*)pk + pv;
            }
        }
        WAVE_SYNC();
        const int cur = t >> 6;
        float sc8[8];
#pragma unroll
        for (int f = 0; f < 8; ++f) {
            const int j = 4 * f + q; float imp = 0.f;
#pragma unroll
            for (int dn = -1; dn <= 3; ++dn) { const int n = 4 * j + dn; if (n >= 0 && n < 128) imp += pkey[l15 * 128 + n]; }
            const bool forced = (j == 0) || (j == cur) || (j == cur - 1);
            sc8[f] = j <= cur ? imp + (forced ? 1.0e4f : 0.f) : NEG;
            impL[l15 * 32 + j] = sc8[f];
        }
        WAVE_SYNC();
        unsigned selmask = 0u;
#pragma unroll
        for (int f = 0; f < 8; ++f) {
            const int j = 4 * f + q; const float sv = sc8[f]; int rank = 0;
            for (int jj = 0; jj < 32; ++jj) { const float sj = impL[l15 * 32 + jj]; rank += (sj > sv || (sj == sv && jj < j)) ? 1 : 0; }
            if (j <= cur && rank < NSEL) selmask |= 1u << j;
        }
        selmask |= __shfl_xor(selmask, 16); selmask |= __shfl_xor(selmask, 32);
        unsigned wsel = selmask; wsel |= __shfl_xor(wsel, 1); wsel |= __shfl_xor(wsel, 2); wsel |= __shfl_xor(wsel, 4); wsel |= __shfl_xor(wsel, 8);
        wsel = (unsigned)UNIFORM((int)wsel);
        unsigned wfull = selmask; wfull &= __shfl_xor(wfull, 1); wfull &= __shfl_xor(wfull, 2); wfull &= __shfl_xor(wfull, 4); wfull &= __shfl_xor(wfull, 8);
        wfull = (unsigned)UNIFORM((int)wfull) & ((1u << (t0 >> 6)) - 1u);
        if (lane == 0) Lmask[w] = wsel;
#pragma unroll
        for (int hh = 0; hh < 4; ++hh) {
            f32x4 Oc[4];
#pragma unroll
            for (int df = 0; df < 4; ++df) Oc[df] = (f32x4){0.f, 0.f, 0.f, 0.f};
#pragma unroll 1
            for (int k2 = 0; 2 * k2 < nkt; ++k2) {
                f32x4 s0 = cmp_tile_lds(Kc, 2 * k2, t, lane, qf[hh][0], qf[hh][1], slope[hh]), s1 = cmp_tile_lds(Kc, 2 * k2 + 1, t, lane, qf[hh][0], qf[hh][1], slope[hh]);
#pragma unroll
                for (int rr = 0; rr < 4; ++rr) { s0[rr] = s0[rr] > 0.5f * NEG ? exp2_fast(s0[rr] - mC[hh]) * ilC[hh] : 0.f; s1[rr] = s1[rr] > 0.5f * NEG ? exp2_fast(s1[rr] - mC[hh]) * ilC[hh] : 0.f; }
                const bf16x8 pf = pack8(s0, s1);
#pragma unroll
                for (int df = 0; df < 4; ++df) { const bf16_t* vp = VcT + (16 * df + l15) * 136 + 32 * k2 + 4 * q; Oc[df] = MFMA16(cat4(*(const bf16x4*)vp, *(const bf16x4*)(vp + 16)), pf, Oc[df]); }
            }
            const float gate = gt[hh * 3];
#pragma unroll
            for (int df = 0; df < 4; ++df) *(f32x4*)(p.aof + (tok * 1024u + (unsigned)((g * 4 + hh) * 64 + 16 * df + 4 * q))) = Oc[df] * gate;
        }
        __syncthreads();
        unsigned U = 0u;
        for (int i = 0; i < 8; ++i) U |= Lmask[i];
        U = (unsigned)UNIFORM((int)U);
#pragma unroll 1
        for (int hp = 0; hp < 2; ++hp) {
            bf16x8 q2[2][2]; float sl2[2];
#pragma unroll
            for (int hh = 0; hh < 2; ++hh) { const int head = g * 4 + 2 * hp + hh; sl2[hh] = alibi_slope(head); for (int ks = 0; ks < 2; ++ks) q2[hh][ks] = *(const bf16x8*)(p.qb + (tok * 1024u + (unsigned)(head * 64 + ks * 32 + q * 8))); }
            float m[2], l[2]; f32x4 O[2][4];
#pragma unroll 1
            for (int br = 0; br < 2; ++br) {
#pragma unroll
                for (int hh = 0; hh < 2; ++hh) { m[hh] = NEG; l[hh] = 0.f; for (int df = 0; df < 4; ++df) O[hh][df] = (f32x4){0.f, 0.f, 0.f, 0.f}; }
                if (br == 0) attn_run_blocks<0>(p, b, g, U, wsel, wfull, t, lane, tid, q2, sl2, selmask, m, l, O, Kt, Vt);
                else {
                    const int jlo_b = (T0 - WINDOW) > 0 ? (T0 - WINDOW) >> 6 : 0, jhi_b = (T0 + 127) >> 6;
                    const int jlo_w = (t0 - WINDOW) > 0 ? (t0 - WINDOW) >> 6 : 0, jhi_w = (t0 + 15) >> 6;
                    const unsigned lb = (jhi_b >= 31 ? 0xffffffffu : ((1u << (jhi_b + 1)) - 1u)) & ~((1u << jlo_b) - 1u);
                    const unsigned lw = (jhi_w >= 31 ? 0xffffffffu : ((1u << (jhi_w + 1)) - 1u)) & ~((1u << jlo_w) - 1u);
                    unsigned lf = 0u; for (int jb = jlo_w; jb <= jhi_w; ++jb) if (64 * jb >= t0 + 15 - WINDOW && 64 * jb + 63 <= t0) lf |= 1u << jb;
                    attn_run_blocks<1>(p, b, g, lb, lw, lf, t, lane, tid, q2, sl2, selmask, m, l, O, Kt, Vt);
                }
#pragma unroll
                for (int hh = 0; hh < 2; ++hh) {
                    float lt = l[hh]; lt += __shfl_xor(lt, 16); lt += __shfl_xor(lt, 32);
                    const float sc = gt[(2 * hp + hh) * 3 + 1 + br] / fmaxf(lt, 1e-30f);
#pragma unroll
                    for (int df = 0; df < 4; ++df) {
                        const unsigned off = tok * 1024u + (unsigned)((g * 4 + 2 * hp + hh) * 64 + 16 * df + 4 * q);
                        const f32x4 v = *(const f32x4*)(p.aof + off) + O[hh][df] * sc;
                        if (br == 0) *(f32x4*)(p.aof + off) = v; else *(bf16x4*)(p.ao + off) = pack4(v);
                    }
                }
            }
        }
    }
}

template <int MODE>
DI void attn_sample_unit(const Params& p, int b, int g, int blk, int lane, const bf16x8 (&qf)[2][2], const float (&slope)[2], const unsigned long long* Lsel, bf16_t* Lvt,
                         float (&m)[2], float (&l)[2], f32x4 (&O)[2][4]) {
    const int l15 = lane & 15, q = lane >> 4;
    auto rowptr = [&](int kk, bool isv) -> const float* {
        if (MODE == 0) { int pos = 64 * blk + kk; pos = pos < PAST + DS ? pos : PAST + DS - 1;
            const int pc = pos < PAST ? pos : PAST - 1;
            const float* pa = p.cache_kv + ((size_t)p.page_table[b * NPAGES + (pc >> 7)] * PAGE + (pc & 127)) * 1024;
            const float* pb = p.kv_sample + ((size_t)(b * DS + (pos < PAST ? 0 : pos - PAST))) * 1024;
            return (pos < PAST ? pa : pb) + (isv ? 768 : 512) + g * 64; }
        int idx = 64 * blk + kk; idx = idx < WBUF + DS ? idx : WBUF + DS - 1;
        const float* pa = p.state_win + ((size_t)b * WBUF + (idx < WBUF ? idx : WBUF - 1)) * 512;
        const float* pb = p.win_sample + ((size_t)b * WINS + WINS - DS + (idx < WBUF ? 0 : idx - WBUF)) * 512;
        return (idx < WBUF ? pa : pb) + (isv ? 256 : 0) + g * 64; };
    bf16x8 kf[4][2];
#pragma unroll
    for (int kt = 0; kt < 4; ++kt) { const float* rp = rowptr(16 * kt + l15, false);
#pragma unroll
        for (int ks = 0; ks < 2; ++ks) kf[kt][ks] = pack8(*(const f32x4*)(rp + ks * 32 + q * 8), *(const f32x4*)(rp + ks * 32 + q * 8 + 4)); }
    f32x4 vraw[8];
#pragma unroll
    for (int it = 0; it < 8; ++it) vraw[it] = *(const f32x4*)(rowptr(it * 4 + q, true) + l15 * 4);
    WAVE_SYNC();
#pragma unroll
    for (int it = 0; it < 8; ++it) { const int kk = it * 4 + q; for (int e = 0; e < 4; ++e) Lvt[(l15 * 4 + e) * 72 + kk] = f2bf(vraw[it][e]); }
#pragma unroll
    for (int it = 0; it < 8; ++it) vraw[it] = *(const f32x4*)(rowptr((it + 8) * 4 + q, true) + l15 * 4);
#pragma unroll
    for (int it = 0; it < 8; ++it) { const int kk = (it + 8) * 4 + q; for (int e = 0; e < 4; ++e) Lvt[(l15 * 4 + e) * 72 + kk] = f2bf(vraw[it][e]); }
    WAVE_SYNC();
    const int i = l15 & 7, tpos = PAST + i;
    const bool tok_ok = MODE == 0 ? (((Lsel[i] >> blk) & 1ull) != 0ull) : true;
    const int kbase = MODE == 0 ? 64 * blk : PAST - WBUF + 64 * blk;
#pragma unroll
    for (int rf = 0; rf < 2; ++rf) {
        f32x4 sT[4];
#pragma unroll
        for (int kt = 0; kt < 4; ++kt) { f32x4 acc = (f32x4){0.f, 0.f, 0.f, 0.f}; acc = MFMA16(kf[kt][0], qf[rf][0], acc); acc = MFMA16(kf[kt][1], qf[rf][1], acc); sT[kt] = acc; }
        float mx = NEG;
#pragma unroll
        for (int kt = 0; kt < 4; ++kt)
#pragma unroll
            for (int r = 0; r < 4; ++r) {
                const int kk = 16 * kt + 4 * q + r, dist = tpos - (kbase + kk);
                const bool valid = tok_ok && dist >= 0 && (MODE == 0 || (dist <= WINDOW && 64 * blk + kk < WBUF + DS));
                const float sv = valid ? sT[kt][r] - slope[rf] * (float)dist : NEG; sT[kt][r] = sv; mx = fmaxf(mx, sv);
            }
        mx = fmaxf(mx, __shfl_xor(mx, 16)); mx = fmaxf(mx, __shfl_xor(mx, 32));
        const float mnew = fmaxf(m[rf], mx), alpha = exp2_fast(m[rf] - mnew);
        float psum = 0.f;
#pragma unroll
        for (int kt = 0; kt < 4; ++kt)
#pragma unroll
            for (int r = 0; r < 4; ++r) { const float pe = sT[kt][r] > 0.5f * NEG ? exp2_fast(sT[kt][r] - mnew) : 0.f; sT[kt][r] = pe; psum += pe; }
        l[rf] = l[rf] * alpha + psum; m[rf] = mnew;
#pragma unroll
        for (int df = 0; df < 4; ++df) O[rf][df] = O[rf][df] * alpha;
#pragma unroll
        for (int ks2 = 0; ks2 < 2; ++ks2) { const bf16x8 pf = pack8(sT[2 * ks2], sT[2 * ks2 + 1]);
#pragma unroll
            for (int df = 0; df < 4; ++df) { const bf16_t* vp = Lvt + (16 * df + l15) * 72 + 32 * ks2 + 4 * q; O[rf][df] = MFMA16(cat4(*(const bf16x4*)vp, *(const bf16x4*)(vp + 16)), pf, O[rf][df]); } }
    }
}
DI void phase_attn_sample(const Params& p, char* lds) {
    const int tid = threadIdx.x, lane = tid & 63, w = tid >> 6, l15 = lane & 15, q = lane >> 4;
    float* Lsc = (float*)lds;
    float* Lpt = Lsc + 32 * 128;
    float* Lscore = Lpt + 8 * 128;
    unsigned long long* Lsel = (unsigned long long*)(Lscore + 8 * 64);
    float* Locmp = (float*)(Lsel + 16);
    bf16_t* Lvt_all = (bf16_t*)(Locmp + 32 * 64);
    float* Lcomb = (float*)Lvt_all;
    constexpr int NWB = (WBUF + DS + 63) / 64;
    for (int item = blockIdx.x; item < DB * GB; item += gridDim.x) {
        const int b = item >> 2, g = item & 3, bb = BATCH + b;
        __syncthreads();
        bf16x8 qf[2][2]; float slope[2];
#pragma unroll
        for (int rf = 0; rf < 2; ++rf) { const int head = 2 * rf + (l15 >> 3), i = l15 & 7; slope[rf] = alibi_slope(g * 4 + head);
            for (int ks = 0; ks < 2; ++ks) qf[rf][ks] = *(const bf16x8*)(p.qb + ((size_t)TP + b * DS + i) * 1024 + (g * 4 + head) * 64 + ks * 32 + q * 8); }
        {
            const bf16_t* kp = p.kc + ((size_t)(bb * NCBS + 16 * w + l15) * 4 + g) * 64 + q * 8;
            const bf16x8 k0 = *(const bf16x8*)kp, k1 = *(const bf16x8*)(kp + 32);
#pragma unroll
            for (int rf = 0; rf < 2; ++rf) {
                f32x4 acc = (f32x4){0.f, 0.f, 0.f, 0.f}; acc = MFMA16(k0, qf[rf][0], acc); acc = MFMA16(k1, qf[rf][1], acc);
                const int R = rf * 16 + l15, tpos = PAST + (l15 & 7);
                for (int r = 0; r < 4; ++r) { const int n = 16 * w + 4 * q + r, cend = 16 * n + 31; Lsc[R * 128 + n] = (n < NCB_S && cend <= tpos) ? acc[r] - slope[rf] * (float)(tpos - cend) : NEG; }
            }
        }
        __syncthreads();
        {
            const int i = w, tpos = PAST + i, cur = tpos >> 6; float pt0 = 0.f, pt1 = 0.f;
            for (int hh = 0; hh < 4; ++hh) {
                const int R = hh * 8 + i; const float s0 = Lsc[R * 128 + lane], s1 = Lsc[R * 128 + 64 + lane];
                const float mx = wave_max(fmaxf(s0, s1));
                const float e0 = s0 > 0.5f * NEG ? exp2_fast(s0 - mx) : 0.f, e1 = s1 > 0.5f * NEG ? exp2_fast(s1 - mx) : 0.f;
                const float inv = 1.0f / fmaxf(wave_sum(e0 + e1), 1e-30f);
                Lsc[R * 128 + lane] = e0 * inv; Lsc[R * 128 + 64 + lane] = e1 * inv; pt0 += e0 * inv; pt1 += e1 * inv;
            }
            Lpt[i * 128 + lane] = pt0; Lpt[i * 128 + 64 + lane] = pt1;
            WAVE_SYNC();
            const int j = lane; float sv = NEG;
            if (j < NSELB_S && j <= cur) { float imp = 0.f; for (int n = 4 * j - 1; n <= 4 * j + 3; ++n) if (n >= 0 && n < NCB_S) imp += Lpt[i * 128 + n];
                const bool forced = (j == 0) || (j == cur) || (j == cur - 1); sv = imp + (forced ? 1.0e4f : 0.f); }
            Lscore[i * 64 + j] = sv;
            WAVE_SYNC();
            int rank = 0; for (int jj = 0; jj < NSELB_S; ++jj) { const float sj = Lscore[i * 64 + jj]; rank += (sj > sv || (sj == sv && jj < j)) ? 1 : 0; }
            const unsigned long long mask = __ballot(j < NSELB_S && j <= cur && rank < NSEL);
            if (lane == 0) Lsel[i] = mask;
        }
        __syncthreads();
        {
            const int df = w >> 1, rf = w & 1, R = rf * 16 + l15; f32x4 acc = (f32x4){0.f, 0.f, 0.f, 0.f};
#pragma unroll
            for (int ks = 0; ks < 4; ++ks) {
                const bf16x8 va = *(const bf16x8*)(p.vcT + ((size_t)(bb * 4 + g) * 64 + 16 * df + l15) * NCBS + 32 * ks + 8 * q);
                const float* pp = Lsc + R * 128 + 32 * ks + 8 * q;
                acc = MFMA16(va, pack8(*(const f32x4*)pp, *(const f32x4*)(pp + 4)), acc);
            }
            for (int r = 0; r < 4; ++r) Locmp[R * 64 + 16 * df + 4 * q + r] = acc[r];
        }
        unsigned long long U = 0ull;
        for (int i = 0; i < 8; ++i) U |= Lsel[i];
        const int nslc = __builtin_popcountll(U);
        bf16_t* Lvt = Lvt_all + w * (64 * 72);
        f32x4 outv = (f32x4){0.f, 0.f, 0.f, 0.f};
        const int cR = tid >> 4, cd = (tid & 15) * 4, chead = cR >> 3, ci = cR & 7;
        const float* gt = p.gates + ((size_t)TP + b * DS + ci) * 48 + (g * 4 + chead) * 3;
#pragma unroll 1
        for (int br = 0; br < 2; ++br) {
            float m[2], l[2]; f32x4 O[2][4];
#pragma unroll
            for (int rf = 0; rf < 2; ++rf) { m[rf] = NEG; l[rf] = 0.f; for (int df = 0; df < 4; ++df) O[rf][df] = (f32x4){0.f, 0.f, 0.f, 0.f}; }
            if (br == 0) {
#pragma unroll 1
                for (int u = w; u < nslc; u += 8) { unsigned long long rem = U; for (int k = 0; k < u; ++k) rem &= rem - 1ull; const int jb = __builtin_ctzll(rem); attn_sample_unit<0>(p, b, g, jb, lane, qf, slope, Lsel, Lvt, m, l, O); }
            } else {
#pragma unroll 1
                for (int u = (w + 8 - (nslc & 7)) & 7; u < NWB; u += 8) attn_sample_unit<1>(p, b, g, u, lane, qf, slope, Lsel, Lvt, m, l, O);
            }
            __syncthreads();
#pragma unroll
            for (int rf = 0; rf < 2; ++rf) {
                float lt = l[rf]; lt += __shfl_xor(lt, 16); lt += __shfl_xor(lt, 32);
                const int R = rf * 16 + l15;
                if (q == 0) { Lcomb[w * 2112 + 2048 + R] = m[rf]; Lcomb[w * 2112 + 2080 + R] = lt; }
#pragma unroll
                for (int df = 0; df < 4; ++df) { for (int r = 0; r < 4; ++r) Lcomb[w * 2112 + R * 64 + 16 * df + 4 * q + r] = O[rf][df][r]; }
            }
            __syncthreads();
            float M = NEG; for (int ww = 0; ww < 8; ++ww) M = fmaxf(M, Lcomb[ww * 2112 + 2048 + cR]);
            float L = 0.f; f32x4 o = (f32x4){0.f, 0.f, 0.f, 0.f};
            for (int ww = 0; ww < 8; ++ww) { const float sc = exp2_fast(Lcomb[ww * 2112 + 2048 + cR] - M); L += Lcomb[ww * 2112 + 2080 + cR] * sc; o += *(const f32x4*)(Lcomb + ww * 2112 + cR * 64 + cd) * sc; }
            outv += o * (gt[1 + br] / fmaxf(L, 1e-30f));
            __syncthreads();
        }
        outv += *(const f32x4*)(Locmp + cR * 64 + cd) * gt[0];
        *(bf16x4*)(p.ao + ((size_t)TP + b * DS + ci) * 1024 + (g * 4 + chead) * 64 + cd) = pack4(outv);
    }
}

constexpr int LDS_BYTES = 147456;
constexpr int NPHASE = 22;
#define PHASE(k) if (p.ph_lo <= (k) && (k) < p.ph_hi)
#define SEAM(k) if (p.ph_lo <= (k) && (k) + 1 < p.ph_hi) grid_barrier(bar)
__global__ void __launch_bounds__(512, 2) mega(Params p) {
    char* lds = lds_base();
#ifdef EMU
    XcdBarrier bar{0};
#else
    if (threadIdx.x == 0) *(uint4*)(lds + LDS_BYTES - 16) = make_uint4(0u, 0u, 0u, 0u);
    __syncthreads();
    XcdBarrier bar = xcd_barrier_post(p.bar, (volatile LAS unsigned*)(lds + LDS_BYTES - 16));
#endif
    PHASE(0) phase_prologue(p, lds);
    SEAM(0);
    PHASE(1) { EpiAda e{p.mod, p.b_ada, p.b_ada_kv}; big_gemm(256, MODN, D, p.scb, p.Wada, e, lds); }
    SEAM(1);
    PHASE(2) phase_normmod<false>(p, true, p.g_mix, 0, D, p.hbuf, nullptr, 0, 0, nullptr);
    SEAM(2);
    PHASE(3) { EpiRetIn e{p.qb, p.kb, p.vb, p.sgb, p.kT, p.vT}; big_gemm(TT, RETP, D, p.hbuf, p.Wret_in, e, lds); }
    SEAM(3);
    PHASE(4) { phase_ret_prompt(p, lds); phase_ret_sample(p, lds); }
    SEAM(4);
    PHASE(5) phase_ret_act(p);
    SEAM(5);
    PHASE(6) { EpiResid e{&p, true, 2 * D}; big_gemm(TP, D, NV, p.actr, p.Wret_out, e, lds); __syncthreads(); gemm_wsplit(TP, TT, D, NV, p.actr, p.Wret_out, e, lds); }
    SEAM(6);
    PHASE(7) phase_normmod<false>(p, false, p.g_ffn, 3 * D, 4 * D, p.hbuf, nullptr, 0, 0, nullptr);
    SEAM(7);
    PHASE(8) { EpiFfnConv e{&p, 0, TT}; big_gemm_raw(TT, F2, D, p.hbuf, p.Wffn_in, e, lds); }
    SEAM(8);
    PHASE(9) phase_conv_fix(p, 0);
    SEAM(9);
    PHASE(10) { EpiResid e{&p, false, 5 * D}; big_gemm(TP, D, DFF, p.actf, p.Wffn_out, e, lds); __syncthreads(); gemm_wsplit(TP, TT, D, DFF, p.actf, p.Wffn_out, e, lds); }
    SEAM(10);
    PHASE(11) phase_normmod<true>(p, false, p.g_mix + D, 6 * D, 7 * D, p.hbuf, p.g_kv, 12 * D, 13 * D, p.hkv);
    SEAM(11);
    PHASE(12) { EpiKv e0{&p}; EpiNsaIn e1{p.qb, p.gates}; big_gemm2(TT, D, p.hkv, p.Wkv, NKV, e0, p.hbuf, p.Wnsa_in, NNSA_PAD, e1, lds); }
    SEAM(12);
    PHASE(13) {
        { EpiZ1 e{p.Z1}; big_gemm(CROWS_P, 256, 1024, p.Acmp, p.Wc1, e, lds); }
        { EpiZ1 e{p.Z1 + (size_t)CROWS * 256}; big_gemm(CROWS_P, 256, 1024, p.Acmp + (size_t)CROWS_PAD * 1024, p.Wc1 + 256 * 1024, e, lds, 128); }
        __syncthreads();
        gemm_cmp_sample(p, 0, p.Wc1, p.Z1 + (size_t)CROWS_P * 256, lds);
        gemm_cmp_sample(p, 1, p.Wc1 + 256 * 1024, p.Z1 + (size_t)(CROWS + CROWS_P) * 256, lds);
    }
    SEAM(13);
    PHASE(14) {
        { EpiCmp2 e{p.kc, p.vcT, 0}; gemm_phase<true>(CROWS, 128, 128, p.Wc2, LoadCmp2{p.Z1, p.cbias}, e, lds); }
        { EpiCmp2 e{p.kc, p.vcT, 1}; gemm_phase<true>(CROWS, 128, 128, p.Wc2 + 128 * 128, LoadCmp2{p.Z1 + (size_t)CROWS * 256, p.cbias + 128}, e, lds); }
    }
    SEAM(14);
    PHASE(15) { phase_attn_sample(p, lds); __syncthreads(); phase_attn_prompt2(p, lds); }
    SEAM(15);
    PHASE(16) { EpiResid e{&p, false, 8 * D}; big_gemm(TP, D, D, p.ao, p.Wnsa_out, e, lds); __syncthreads(); gemm_wsplit(TP, TT, D, D, p.ao, p.Wnsa_out, e, lds); }
    SEAM(16);
    PHASE(17) phase_normmod<false>(p, false, p.g_ffn + D, 9 * D, 10 * D, p.hbuf, nullptr, 0, 0, nullptr);
    SEAM(17);
    PHASE(18) { EpiFfnConv e{&p, 1, TT}; big_gemm_raw(TT, F2, D, p.hbuf, p.Wffn_in + (size_t)F2 * D, e, lds); }
    SEAM(18);
    PHASE(19) phase_conv_fix(p, 1);
    SEAM(19);
    PHASE(20) { EpiResid e{&p, false, 11 * D}; big_gemm(TP, D, DFF, p.actf, p.Wffn_out + (size_t)D * DFF, e, lds); __syncthreads(); gemm_wsplit(TP, TT, D, DFF, p.actf, p.Wffn_out + (size_t)D * DFF, e, lds); }
    SEAM(20);
    PHASE(21) phase_final_norm(p);
}

extern "C" void kernel_launch(void* const* d_in, const int* in_sizes, int n_in, void* d_out, int out_size, void* d_ws, size_t ws_size, hipStream_t stream) {
    Params p{};
    const float** fin = (const float**)&p.x_prompt;
    p.x_prompt = (const float*)d_in[0]; p.x_sample = (const float*)d_in[1]; p.c_prompt = (const float*)d_in[2]; p.c_sample = (const float*)d_in[3];
    p.state_ret = (const float*)d_in[4]; p.state_conv = (const float*)d_in[5]; p.cache_kv = (const float*)d_in[6]; p.state_win = (const float*)d_in[7];
    p.page_table = (const int*)d_in[8];
    p.w_ada = (const float*)d_in[9]; p.b_ada = (const float*)d_in[10]; p.g_mix = (const float*)d_in[11]; p.g_ffn = (const float*)d_in[12];
    p.w_ffn_in = (const float*)d_in[13]; p.conv_w = (const float*)d_in[14]; p.conv_b = (const float*)d_in[15]; p.w_ffn_out = (const float*)d_in[16];
    p.w_ret_in = (const float*)d_in[17]; p.w_ret_out = (const float*)d_in[18]; p.g_kv = (const float*)d_in[19]; p.w_ada_kv = (const float*)d_in[20];
    p.b_ada_kv = (const float*)d_in[21]; p.w_kv = (const float*)d_in[22]; p.pe_ck = (const float*)d_in[23]; p.pe_cv = (const float*)d_in[24];
    p.w_ck1 = (const float*)d_in[25]; p.w_ck2 = (const float*)d_in[26]; p.w_cv1 = (const float*)d_in[27]; p.w_cv2 = (const float*)d_in[28];
    p.w_nsa_in = (const float*)d_in[29]; p.w_nsa_out = (const float*)d_in[30]; p.g_final = (const float*)d_in[31];
    (void)fin;
    float* o = (float*)d_out;
    p.y_prompt = o; o += (size_t)TP * D; p.y_sample = o; o += (size_t)TS * D;
    p.ret_prompt = o; o += (size_t)BATCH * HA * DK * DV; p.ret_sample = o; o += (size_t)DB * HA * DK * DV;
    p.conv_prompt = o; o += (size_t)2 * BATCH * 2 * F2; p.conv_sample = o; o += (size_t)2 * DB * 2 * F2;
    p.kv_prompt = o; o += (size_t)TP * 1024; p.kv_sample = o; o += (size_t)TS * 1024;
    p.win_prompt = o; o += (size_t)BATCH * WINP * 512; p.win_sample = o; o += (size_t)DB * WINS * 512;
    WsAlloc A;
    p.bar = A.take<unsigned>(d_ws, XCD_BAR_WORDS);
    p.Wada = A.take<bf16_t>(d_ws, (size_t)MODN * D); p.Wret_in = A.take<bf16_t>(d_ws, (size_t)RETP * D); p.Wret_out = A.take<bf16_t>(d_ws, (size_t)D * NV);
    p.Wffn_in = A.take<bf16_t>(d_ws, (size_t)2 * F2 * D); p.Wffn_out = A.take<bf16_t>(d_ws, (size_t)2 * D * DFF); p.Wkv = A.take<bf16_t>(d_ws, (size_t)NKV * D);
    p.Wnsa_in = A.take<bf16_t>(d_ws, (size_t)NNSA_PAD * D); p.Wnsa_out = A.take<bf16_t>(d_ws, (size_t)D * D); p.Wc1 = A.take<bf16_t>(d_ws, (size_t)512 * 1024); p.Wc2 = A.take<bf16_t>(d_ws, 2 * 128 * 128);
    p.cbias = A.take<float>(d_ws, 256); p.mod = A.take<float>(d_ws, (size_t)NBAT * MODN); p.X = A.take<bf16_t>(d_ws, (size_t)TT * D);
    p.ssq = A.take<float>(d_ws, (size_t)TT * 32); p.gates = A.take<float>(d_ws, (size_t)TT * 48); p.Z1 = A.take<bf16_t>(d_ws, (size_t)2 * CROWS * 256); p.aof = A.take<float>(d_ws, (size_t)TP * D);
    p.Acmp = A.take<bf16_t>(d_ws, (size_t)2 * CROWS_PAD * 1024); p.scb = A.take<bf16_t>(d_ws, 256 * D); p.hbuf = A.take<bf16_t>(d_ws, (size_t)TT * D); p.hkv = A.take<bf16_t>(d_ws, (size_t)TT * D);
    p.qb = A.take<bf16_t>(d_ws, (size_t)TT * D); p.kb = A.take<bf16_t>(d_ws, (size_t)TT * D); p.vb = A.take<bf16_t>(d_ws, (size_t)TT * NV); p.sgb = A.take<bf16_t>(d_ws, (size_t)TT * NV);
    p.kT = A.take<bf16_t>(d_ws, (size_t)TP * NQ); p.vT = A.take<bf16_t>(d_ws, (size_t)TP * NV); p.obuf = A.take<bf16_t>(d_ws, (size_t)TT * NV); p.actr = A.take<bf16_t>(d_ws, (size_t)TT * NV);
    p.u = A.take<bf16_t>(d_ws, (size_t)TT * F2); p.uh = A.take<bf16_t>(d_ws, (size_t)((TT + 63) / 64 + 4) * 4 * F2); p.actf = A.take<bf16_t>(d_ws, (size_t)TT * DFF); p.kvb = A.take<bf16_t>(d_ws, (size_t)TP * NKV);
    p.vTs = A.take<bf16_t>(d_ws, (size_t)TP * 256); p.vTw = A.take<bf16_t>(d_ws, (size_t)TP * 256);
    p.kc = A.take<bf16_t>(d_ws, (size_t)NBAT * NCBS * 256); p.vcT = A.take<bf16_t>(d_ws, (size_t)NBAT * NCBS * 256); p.ao = A.take<bf16_t>(d_ws, (size_t)TT * D);
    if (A.off > ws_size) { fprintf(stderr, "kernel_launch: workspace too small (%zu > %zu)\n", A.off, ws_size); return; }
    hipMemsetAsync(p.bar, 0, XCD_BAR_WORDS * sizeof(unsigned), stream);
#ifdef EMU
    const int grid = 4;
    emu_dbg_register("mod", p.mod, (size_t)NBAT * MODN, 0);
    emu_dbg_register("hbuf", p.hbuf, (size_t)TT * D, 1);
    emu_dbg_register("ao", p.ao, (size_t)TT * D, 1); emu_dbg_register("nq", p.qb, (size_t)TT * D, 1); emu_dbg_register("gates", p.gates, (size_t)TT * 48, 0);
    emu_dbg_register("kc", p.kc, (size_t)NBAT * NCBS * 256, 1); emu_dbg_register("vcT", p.vcT, (size_t)NBAT * NCBS * 256, 1); emu_dbg_register("X1", p.X, (size_t)TT * D, 1);
    emu_dbg_register("obuf", p.obuf, (size_t)TT * NV, 1); emu_dbg_register("actr", p.actr, (size_t)TT * NV, 1);
    emu_dbg_register("actf1", p.actf, (size_t)TT * DFF, 1);
    emu_dbg_register("kb", p.kb, (size_t)TT * D, 1); emu_dbg_register("vb", p.vb, (size_t)TT * NV, 1); emu_dbg_register("sgb", p.sgb, (size_t)TT * NV, 1);
#else
    static int grid = 0;
    if (grid == 0) {
        int dev = 0, cus = 0;
        if (hipGetDevice(&dev) != hipSuccess || hipDeviceGetAttribute(&cus, hipDeviceAttributeMultiprocessorCount, dev) != hipSuccess) { fprintf(stderr, "kernel_launch: device query failed\n"); grid = -1; return; }
        if (hipFuncSetAttribute((const void*)mega, hipFuncAttributeMaxDynamicSharedMemorySize, LDS_BYTES) != hipSuccess) { fprintf(stderr, "kernel_launch: hipFuncSetAttribute failed\n"); grid = -1; return; }
        (void)hipGetLastError();
        grid = cus;
    }
    if (grid < 0) return;
#endif
    p.ph_lo = 0; p.ph_hi = NPHASE;
    LAUNCH(mega, grid, 512, LDS_BYTES, stream, p);
}
```
